# Optimizing an MI355X kernel written in HIP

```python
import math
import jax, jax.numpy as jnp
from jax import lax
import numpy as np

D_MODEL = 1024
BATCH = 32
SEQ = 256
DEPTH = 4
DEC_BATCH = 8
DEC_SEQ = 4096
PAST_LEN = 512

GRID_W = 64
N_MIXERS = 2
N_SSM_LAYERS = (DEPTH + 1) // 2
N_ATTN_LAYERS = DEPTH // 2
SSM_GROUP = 16
SSM_GROUPS = D_MODEL // SSM_GROUP
SSM_STATE = 64
DT_MIN = 1e-3
DT_MAX = 1e-1
HEAD_DIM = 64
N_HEADS = D_MODEL // HEAD_DIM
N_KV_HEADS = 4
KV_REP = N_HEADS // N_KV_HEADS
WINDOW = 128
ATTN_BLOCK = 128
ROPE_BASE = 10000.0
ROPE_AXIS_DIM = HEAD_DIM // 2
QKV_DIM = (N_HEADS + 2 * N_KV_HEADS) * HEAD_DIM
PEER_HEADS = 8
PEER_NKEYS = 128
PEER_EXPERTS = PEER_NKEYS * PEER_NKEYS
PEER_TOPK = 16
PEER_KEY_DIM = 256
PEER_HALF = PEER_KEY_DIM // 2
PEER_CHUNK = 128
DN_ALPHA = (2 * DEPTH) ** 0.25
DN_BETA = (8 * DEPTH) ** -0.25
LN_EPS = 1e-5
NEG_INF = -1e30

kernel_name = 'hybrid_s5_swa_peer_diffusion_step'


def _layer_norm(x, g, b):
    xf = x.astype(jnp.float32)
    mu = jnp.mean(xf, axis=-1, keepdims=True)
    var = jnp.mean(jnp.square(xf - mu), axis=-1, keepdims=True)
    y = (xf - mu) * lax.rsqrt(var + LN_EPS) * g.astype(jnp.float32) + b.astype(jnp.float32)
    return y.astype(x.dtype)


def _modulation(cond, w_mod, b_mod):
    m = jax.nn.silu(cond.astype(jnp.float32)).astype(w_mod.dtype) @ w_mod + b_mod
    return [t[:, None, :] for t in jnp.split(m, 6, axis=-1)]


def _modulate(x, shift, scale):
    return x * (1.0 + scale) + shift


def _post_norm(x, out, gate, g, b):
    return _layer_norm(DN_ALPHA * x + (1.0 + gate) * out, g, b)


def _rope_2d(x):
    L = x.shape[1]
    rows = L // GRID_W
    row = jnp.repeat(jnp.arange(rows, dtype=jnp.float32), GRID_W)
    col = jnp.tile(jnp.arange(GRID_W, dtype=jnp.float32), rows)
    n_freq = ROPE_AXIS_DIM // 2
    inv = ROPE_BASE ** (-jnp.arange(n_freq, dtype=jnp.float32) / n_freq)

    def rot(seg, pos):
        ang = pos[:, None] * inv[None, :]
        cos = jnp.cos(ang)[None, :, None, :]
        sin = jnp.sin(ang)[None, :, None, :]
        s1, s2 = seg[..., :n_freq], seg[..., n_freq:]
        return jnp.concatenate([s1 * cos - s2 * sin, s1 * sin + s2 * cos], axis=-1)

    xf = x.astype(jnp.float32)
    y = jnp.concatenate([rot(xf[..., :ROPE_AXIS_DIM], row), rot(xf[..., ROPE_AXIS_DIM:], col)], axis=-1)
    return y.astype(x.dtype)


def _s5_scan_dir(u_c, a_re, a_im, log_dt, b_re, b_im, c_re, c_im, h0):
    A = lax.complex(a_re.astype(jnp.float32), a_im.astype(jnp.float32))
    dt = jnp.exp(log_dt.astype(jnp.float32))[:, None]
    A_bar = jnp.exp(A * dt)
    Bm = lax.complex(b_re.astype(jnp.float32), b_im.astype(jnp.float32))
    B_bar = ((A_bar - 1.0) / A)[..., None] * Bm
    Cm = lax.complex(c_re.astype(jnp.float32), c_im.astype(jnp.float32))
    bu = jnp.einsum('blgc,gpc->blgp', u_c, B_bar)
    bu = bu.at[:, 0].add(A_bar[None] * h0)
    a = jnp.broadcast_to(A_bar, (1,) + bu.shape[1:])

    def combine(e1, e2):
        a1, b1 = e1
        a2, b2 = e2
        return a1 * a2, a2 * b1 + b2

    _, hs = lax.associative_scan(combine, (a, bu), axis=1)
    y = jnp.real(jnp.einsum('blgp,gcp->blgc', hs, Cm))
    return y, hs[:, -1]


def _s5_mixer(h, h0_re, h0_im, w_in, a_re, a_im, log_dt, b_re, b_im, c_re, c_im, d_skip, w_glu, w_out):
    Bsz, L, _ = h.shape
    u = (h @ w_in).astype(jnp.float32)
    u_c = u.astype(jnp.complex64).reshape(Bsz, L, SSM_GROUPS, SSM_GROUP)
    h0 = lax.complex(h0_re.astype(jnp.float32), h0_im.astype(jnp.float32))
    y_f, s_f = _s5_scan_dir(u_c, a_re[0], a_im[0], log_dt[0], b_re[0], b_im[0], c_re[0], c_im[0], h0[:, 0])
    y_b, s_b = _s5_scan_dir(jnp.flip(u_c, axis=1), a_re[1], a_im[1], log_dt[1], b_re[1], b_im[1],
                            c_re[1], c_im[1], h0[:, 1])
    y = (y_f + jnp.flip(y_b, axis=1)).reshape(Bsz, L, D_MODEL) + d_skip.astype(jnp.float32) * u
    y = jax.nn.gelu(y).astype(h.dtype)
    val, gate = jnp.split(y @ w_glu, 2, axis=-1)
    out = (val * jax.nn.sigmoid(gate)) @ w_out
    s = jnp.stack([s_f, s_b], axis=1)
    return out, jnp.real(s), jnp.imag(s)


def _project_qkv(h, w_qkv):
    Bsz, L, _ = h.shape
    qkv = h @ w_qkv
    nq = N_HEADS * HEAD_DIM
    nk = N_KV_HEADS * HEAD_DIM
    q = qkv[..., :nq].reshape(Bsz, L, N_HEADS, HEAD_DIM)
    k = qkv[..., nq:nq + nk].reshape(Bsz, L, N_KV_HEADS, HEAD_DIM)
    v = qkv[..., nq + nk:].reshape(Bsz, L, N_KV_HEADS, HEAD_DIM)
    return q, k, v


def _block_attention(q, k_ctx, v_ctx, sink, k_lat=None, v_lat=None):
    Bsz, T = q.shape[0], q.shape[1]
    Lc = k_ctx.shape[1]
    nb = T // ATTN_BLOCK
    scale = HEAD_DIM ** -0.5
    sink_l = sink.astype(jnp.float32).reshape(1, N_KV_HEADS, KV_REP, 1, 1)
    span = ATTN_BLOCK + 2 * WINDOW
    if k_lat is not None:
        pad = ((0, 0), (WINDOW, WINDOW), (0, 0), (0, 0))
        k_pad = jnp.pad(k_lat, pad)
        v_pad = jnp.pad(v_lat, pad)
        qi = jnp.arange(ATTN_BLOCK)[:, None]
        kj = jnp.arange(span)[None, :]
        rel_ok = (kj - qi >= 0) & (kj - qi <= 2 * WINDOW)

    def one_block(b):
        q_b = lax.dynamic_slice_in_dim(q, b * ATTN_BLOCK, ATTN_BLOCK, axis=1)
        q_b = q_b.reshape(Bsz, ATTN_BLOCK, N_KV_HEADS, KV_REP, HEAD_DIM)
        logits = [jnp.broadcast_to(sink_l, (Bsz, N_KV_HEADS, KV_REP, ATTN_BLOCK, 1)),
                  jnp.einsum('bqgrd,bkgd->bgrqk', q_b, k_ctx).astype(jnp.float32) * scale]
        if k_lat is not None:
            k_b = lax.dynamic_slice_in_dim(k_pad, b * ATTN_BLOCK, span, axis=1)
            v_b = lax.dynamic_slice_in_dim(v_pad, b * ATTN_BLOCK, span, axis=1)
            kpos = b * ATTN_BLOCK - WINDOW + kj
            ok = rel_ok & (kpos >= 0) & (kpos < T)
            s_loc = jnp.einsum('bqgrd,bkgd->bgrqk', q_b, k_b).astype(jnp.float32) * scale
            logits.append(jnp.where(ok, s_loc, NEG_INF))
        p = jax.nn.softmax(jnp.concatenate(logits, axis=-1), axis=-1)
        out = jnp.einsum('bgrqk,bkgd->bqgrd', p[..., 1:1 + Lc].astype(v_ctx.dtype), v_ctx)
        if k_lat is not None:
            out = out + jnp.einsum('bgrqk,bkgd->bqgrd', p[..., 1 + Lc:].astype(v_b.dtype), v_b)
        return out.reshape(Bsz, ATTN_BLOCK, N_HEADS * HEAD_DIM)

    out = lax.map(one_block, jnp.arange(nb))
    return jnp.transpose(out, (1, 0, 2, 3)).reshape(Bsz, T, N_HEADS * HEAD_DIM)


def _attn_context(h, w_qkv, sink, w_out):
    q, k, v = _project_qkv(h, w_qkv)
    out = _block_attention(q, k, v, sink)
    return out.astype(h.dtype) @ w_out, k, v


def _attn_latent(h, k_ctx, v_ctx, w_qkv, sink, w_out):
    q, k, v = _project_qkv(h, w_qkv)
    q = _rope_2d(q)
    k = _rope_2d(k)
    out = _block_attention(q, k_ctx, v_ctx, sink, k, v)
    return out.astype(h.dtype) @ w_out


def _peer(h, w_q, keys, u_tab, v_tab):
    Bsz, L, _ = h.shape
    T = Bsz * L
    x = h.reshape(T, D_MODEL)
    q = (x @ w_q).reshape(T, PEER_HEADS, 2, PEER_HALF)
    s1 = jnp.einsum('thd,hnd->thn', q[:, :, 0], keys[0])
    s2 = jnp.einsum('thd,hnd->thn', q[:, :, 1], keys[1])
    v1, i1 = lax.top_k(s1, PEER_TOPK)
    v2, i2 = lax.top_k(s2, PEER_TOPK)
    cand = (v1[..., :, None] + v2[..., None, :]).reshape(T, PEER_HEADS, PEER_TOPK * PEER_TOPK)
    cand_idx = (i1[..., :, None] * PEER_NKEYS + i2[..., None, :]).reshape(T, PEER_HEADS, PEER_TOPK * PEER_TOPK)
    top, pos = lax.top_k(cand, PEER_TOPK)
    idx = jnp.take_along_axis(cand_idx, pos, axis=-1)
    g = jax.nn.softmax(top.astype(jnp.float32), axis=-1).astype(h.dtype)
    nc = T // PEER_CHUNK

    def chunk(args):
        xc, ic, gc = args
        u = u_tab[ic]
        act = jax.nn.gelu(jnp.einsum('chkd,cd->chk', u, xc)) * gc
        return jnp.einsum('chk,chkd->cd', act, v_tab[ic])

    out = lax.map(chunk, (x.reshape(nc, PEER_CHUNK, D_MODEL),
                          idx.reshape(nc, PEER_CHUNK, PEER_HEADS, PEER_TOPK),
                          g.reshape(nc, PEER_CHUNK, PEER_HEADS, PEER_TOPK)))
    return out.reshape(Bsz, L, D_MODEL)


def setup_inputs(seed: int = 0) -> dict:
    key = jax.random.key(seed)
    ks = jax.random.split(key, 32)
    f32 = jnp.float32
    inv_d = D_MODEL ** -0.5

    def nrm(k, shape, s=1.0):
        return jax.random.normal(k, shape, f32) * s

    ssm_shape = (N_SSM_LAYERS, 2, SSM_GROUPS, SSM_STATE)
    a_im_init = math.pi * jnp.arange(SSM_STATE, dtype=f32)
    return {
        'x_prompt': nrm(ks[0], (BATCH, SEQ, D_MODEL)),
        'x_sample': nrm(ks[1], (DEC_BATCH, DEC_SEQ, D_MODEL)),
        'state_ssm_re': nrm(ks[2], (DEC_BATCH, N_SSM_LAYERS, 2, SSM_GROUPS, SSM_STATE), 0.3),
        'state_ssm_im': nrm(ks[3], (DEC_BATCH, N_SSM_LAYERS, 2, SSM_GROUPS, SSM_STATE), 0.3),
        'cache_k': nrm(ks[4], (DEC_BATCH, N_ATTN_LAYERS, PAST_LEN, N_KV_HEADS, HEAD_DIM)),
        'cache_v': nrm(ks[5], (DEC_BATCH, N_ATTN_LAYERS, PAST_LEN, N_KV_HEADS, HEAD_DIM)),
        'c': nrm(ks[6], (DEC_BATCH, D_MODEL)),
        'c_ctx': nrm(ks[7], (D_MODEL,)),
        'w_mod': nrm(ks[8], (DEPTH, D_MODEL, 6 * D_MODEL), 0.5 * inv_d),
        'b_mod': nrm(ks[9], (DEPTH, 6 * D_MODEL), 0.01),
        'ln_g': 1.0 + nrm(ks[10], (DEPTH, 2, D_MODEL), 0.01),
        'ln_b': nrm(ks[11], (DEPTH, 2, D_MODEL), 0.01),
        'ssm_w_in': nrm(ks[12], (N_SSM_LAYERS, D_MODEL, D_MODEL), inv_d),
        'ssm_a_re': -0.5 + nrm(ks[13], ssm_shape, 0.01),
        'ssm_a_im': a_im_init + nrm(ks[14], ssm_shape, 0.01),
        'ssm_log_dt': jax.random.uniform(ks[15], (N_SSM_LAYERS, 2, SSM_GROUPS), f32,
                                         math.log(DT_MIN), math.log(DT_MAX)),
        'ssm_b_re': nrm(ks[16], ssm_shape + (SSM_GROUP,), (2 * SSM_GROUP) ** -0.5),
        'ssm_b_im': nrm(ks[17], ssm_shape + (SSM_GROUP,), (2 * SSM_GROUP) ** -0.5),
        'ssm_c_re': nrm(ks[18], (N_SSM_LAYERS, 2, SSM_GROUPS, SSM_GROUP, SSM_STATE), SSM_STATE ** -0.5),
        'ssm_c_im': nrm(ks[19], (N_SSM_LAYERS, 2, SSM_GROUPS, SSM_GROUP, SSM_STATE), SSM_STATE ** -0.5),
        'ssm_d': nrm(ks[20], (N_SSM_LAYERS, D_MODEL)),
        'ssm_w_glu': nrm(ks[21], (N_SSM_LAYERS, D_MODEL, 2 * D_MODEL), inv_d),
        'ssm_w_out': nrm(ks[22], (N_SSM_LAYERS, D_MODEL, D_MODEL), inv_d * DN_BETA),
        'attn_w_qkv': nrm(ks[23], (N_ATTN_LAYERS, D_MODEL, QKV_DIM), inv_d),
        'attn_sink': nrm(ks[24], (N_ATTN_LAYERS, N_HEADS)),
        'attn_w_out': nrm(ks[25], (N_ATTN_LAYERS, D_MODEL, D_MODEL), inv_d * DN_BETA),
        'peer_w_q': nrm(ks[26], (DEPTH, D_MODEL, PEER_HEADS * PEER_KEY_DIM), inv_d),
        'peer_keys': nrm(ks[27], (DEPTH, 2, PEER_HEADS, PEER_NKEYS, PEER_HALF), PEER_HALF ** -0.5),
        'peer_u': nrm(ks[28], (DEPTH, PEER_EXPERTS, D_MODEL), inv_d),
        'peer_v': nrm(ks[29], (DEPTH, PEER_EXPERTS, D_MODEL), DN_BETA * PEER_HEADS ** -0.5),
    }


def reference(x_prompt, x_sample, state_ssm_re, state_ssm_im, cache_k, cache_v, c, c_ctx,
              w_mod, b_mod, ln_g, ln_b,
              ssm_w_in, ssm_a_re, ssm_a_im, ssm_log_dt, ssm_b_re, ssm_b_im, ssm_c_re, ssm_c_im,
              ssm_d, ssm_w_glu, ssm_w_out,
              attn_w_qkv, attn_sink, attn_w_out,
              peer_w_q, peer_keys, peer_u, peer_v):
    xc = x_prompt
    xs = x_sample
    n_ctx_batch = x_prompt.shape[0]
    st_re, st_im, st_k, st_v = [], [], [], []
    for i in range(DEPTH):
        j = i // N_MIXERS
        mc = _modulation(c_ctx[None, :], w_mod[i], b_mod[i])
        ms = _modulation(c, w_mod[i], b_mod[i])
        hc = _modulate(xc, mc[0], mc[1])
        hs = _modulate(xs, ms[0], ms[1])
        if i % N_MIXERS == 0:
            p = (ssm_w_in[j], ssm_a_re[j], ssm_a_im[j], ssm_log_dt[j], ssm_b_re[j], ssm_b_im[j],
                 ssm_c_re[j], ssm_c_im[j], ssm_d[j], ssm_w_glu[j], ssm_w_out[j])
            zeros = jnp.zeros((n_ctx_batch, 2, SSM_GROUPS, SSM_STATE), jnp.float32)
            oc, s_re, s_im = _s5_mixer(hc, zeros, zeros, *p)
            os_, _, _ = _s5_mixer(hs, state_ssm_re[:, j], state_ssm_im[:, j], *p)
            st_re.append(s_re)
            st_im.append(s_im)
        else:
            oc, k_c, v_c = _attn_context(hc, attn_w_qkv[j], attn_sink[j], attn_w_out[j])
            os_ = _attn_latent(hs, cache_k[:, j], cache_v[:, j], attn_w_qkv[j], attn_sink[j], attn_w_out[j])
            st_k.append(k_c)
            st_v.append(v_c)
        xc = _post_norm(xc, oc, mc[2], ln_g[i, 0], ln_b[i, 0])
        xs = _post_norm(xs, os_, ms[2], ln_g[i, 0], ln_b[i, 0])
        hc = _modulate(xc, mc[3], mc[4])
        hs = _modulate(xs, ms[3], ms[4])
        oc = _peer(hc, peer_w_q[i], peer_keys[i], peer_u[i], peer_v[i])
        os_ = _peer(hs, peer_w_q[i], peer_keys[i], peer_u[i], peer_v[i])
        xc = _post_norm(xc, oc, mc[5], ln_g[i, 1], ln_b[i, 1])
        xs = _post_norm(xs, os_, ms[5], ln_g[i, 1], ln_b[i, 1])
    new_state_ssm_re = jnp.stack(st_re, axis=1)
    new_state_ssm_im = jnp.stack(st_im, axis=1)
    new_cache_k = jnp.stack(st_k, axis=1)
    new_cache_v = jnp.stack(st_v, axis=1)
    return (xc, xs, new_state_ssm_re, new_state_ssm_im, new_cache_k, new_cache_v)
```

```cpp
#include <hip/hip_runtime.h>
#include <hip/hip_cooperative_groups.h>
#include <stdint.h>
#include <stdio.h>
#include <string.h>
namespace cg = cooperative_groups;

#ifndef MULTI_LAUNCH
#define MULTI_LAUNCH 0
#endif

#define DI __device__ __forceinline__
typedef unsigned short bf16;
typedef __attribute__((ext_vector_type(8))) short bf16x8;
typedef __attribute__((ext_vector_type(16))) float f32x16;
typedef __attribute__((ext_vector_type(4))) float f32x4;
typedef __attribute__((ext_vector_type(4))) unsigned u32x4;
typedef __attribute__((ext_vector_type(2))) unsigned u32x2;
typedef __bf16 bf2_t __attribute__((ext_vector_type(2)));
typedef float fl2_t __attribute__((ext_vector_type(2)));

#define MFMA32(a, b, c) __builtin_amdgcn_mfma_f32_32x32x16_bf16((a), (b), (c), 0, 0, 0)

constexpr int D = 1024;
constexpr int NCTX = 8192;
constexpr int NTOK = 40960;
constexpr int DEPTH = 4;
constexpr float DN_ALPHA = 1.681792830507429f;
constexpr float LN_EPS = 1e-5f;

constexpr size_t OUT_Y = 0;
constexpr size_t OUT_SRE = 41943040;
constexpr size_t OUT_SIM = 42467328;
constexpr size_t OUT_CK = 42991616;
constexpr size_t OUT_CV = 47185920;

constexpr size_t MiB = 1048576;
constexpr size_t WS_WIN = 0;
constexpr size_t WS_WGLU = WS_WIN + 4 * MiB;
constexpr size_t WS_WOUT = WS_WGLU + 8 * MiB;
constexpr size_t WS_WQKV = WS_WOUT + 4 * MiB;
constexpr size_t WS_AWOUT = WS_WQKV + 6 * MiB;
constexpr size_t WS_WQ = WS_AWOUT + 4 * MiB;
constexpr size_t WS_KEYS = WS_WQ + 16 * MiB;
constexpr size_t WS_PU = WS_KEYS + 2 * MiB;
constexpr size_t WS_PV = WS_PU + 128 * MiB;
constexpr size_t WS_CK = WS_PV + 128 * MiB;
constexpr size_t WS_CV = WS_CK + 4 * MiB;
constexpr size_t WS_MOD = WS_CV + 4 * MiB;
constexpr size_t WS_ROPE = WS_MOD + 1 * MiB;
constexpr size_t WS_X = WS_ROPE + 1 * MiB;
constexpr size_t WS_H = WS_X + 160 * MiB;
constexpr size_t WS_U = WS_H + 80 * MiB;
constexpr size_t WS_YF = WS_U + 80 * MiB;
constexpr size_t WS_YB = WS_YF + 80 * MiB;
constexpr size_t WS_Z = WS_YB + 80 * MiB;
constexpr size_t WS_IDX = WS_Z + 80 * MiB;
constexpr size_t WS_G = WS_IDX + 20 * MiB;
constexpr size_t WS_BAR = WS_G + 20 * MiB;
constexpr size_t WS_ACT = WS_BAR + 1 * MiB;
constexpr size_t WS_END = WS_ACT + 20 * MiB;

struct Params {
  const float *x_prompt, *x_sample, *st_re, *st_im, *cache_k, *cache_v, *c, *c_ctx, *w_mod, *b_mod, *ln_g, *ln_b;
  const float *ssm_w_in, *ssm_a_re, *ssm_a_im, *ssm_log_dt, *ssm_b_re, *ssm_b_im, *ssm_c_re, *ssm_c_im, *ssm_d, *ssm_w_glu, *ssm_w_out;
  const float *attn_w_qkv, *attn_sink, *attn_w_out, *peer_w_q, *peer_keys, *peer_u, *peer_v;
  float* out;
  char* ws;
  int p0, p1;
};

DI int tidx() { int t = (int)__builtin_amdgcn_workitem_id_x(); asm volatile("" : "+v"(t)); return t; }
DI unsigned pack_bf16(float lo, float hi) { fl2_t f = {lo, hi}; bf2_t b = __builtin_convertvector(f, bf2_t); return __builtin_bit_cast(unsigned, b); }
DI float bf_lo(unsigned w) { return __uint_as_float(w << 16); }
DI float bf_hi(unsigned w) { return __uint_as_float(w & 0xffff0000u); }
DI float bf1(bf16 v) { return __uint_as_float(((unsigned)v) << 16); }
DI bf16 f2bf(float x) { return (bf16)(pack_bf16(x, 0.f) & 0xffffu); }
DI float gelu_tanh(float x) { float z = 0.7978845608028654f * (x + 0.044715f * x * x * x); return x / (1.f + __expf(-2.f * z)); }
DI float sigmoidf_(float x) { return 1.f / (1.f + __expf(-x)); }
DI int crow(int i, int h) { return (i & 3) + 8 * (i >> 2) + 4 * h; }
DI int cond_of(int tok) { return tok < NCTX ? 0 : 1 + ((tok - NCTX) >> 12); }
DI void wave_fence() { asm volatile("" ::: "memory"); __builtin_amdgcn_wave_barrier(); asm volatile("" ::: "memory"); }
DI float wave_sum(float v) {
#pragma unroll
  for (int o = 32; o > 0; o >>= 1) v += __shfl_xor(v, o);
  return v;
}
DI int imax(int a, int b) { return a > b ? a : b; }
DI int imin(int a, int b) { return a < b ? a : b; }
DI int f2key(float f) { int b = __float_as_int(f); return b ^ ((b >> 31) & 0x7fffffff); }
DI int key2bits(int k) { return k ^ ((k >> 31) & 0x7fffffff); }
DI int bsel(int mask, int a, int b) { return (a & ~mask) | (b & mask); }

DI void cswap(int& a, int& b) { int mx = imax(a, b), mn = imin(a, b); a = mx; b = mn; }
template <int N, int OFF>
DI void sort16_desc(int (&v)[N]) {
#pragma unroll
  for (int k = 2; k <= 16; k <<= 1) {
#pragma unroll
    for (int jj = k >> 1; jj > 0; jj >>= 1) {
#pragma unroll
      for (int i = 0; i < 16; ++i) {
        const int l = i ^ jj;
        if (l > i) {
          if ((i & k) == 0) cswap(v[OFF + i], v[OFF + l]);
          else cswap(v[OFF + l], v[OFF + i]);
        }
      }
    }
  }
}
template <int N, int OA, int OB>
DI void merge16_desc(int (&v)[N]) {
#pragma unroll
  for (int i = 0; i < 16; ++i) v[OA + i] = imax(v[OA + i], v[OB + 15 - i]);
#pragma unroll
  for (int jj = 8; jj > 0; jj >>= 1) {
#pragma unroll
    for (int i = 0; i < 16; ++i) {
      const int l = i ^ jj;
      if (l > i) cswap(v[OA + i], v[OA + l]);
    }
  }
}
template <int N>
DI void pair_merge16(int (&v)[N]) {
  static_assert(N >= 32, "");
#pragma unroll
  for (int i = 0; i < 16; ++i) v[16 + i] = __shfl_xor(v[i], 32);
  merge16_desc<N, 0, 16>(v);
}

constexpr int BK = 64;
constexpr int LROW = 144;
constexpr int TILE_BYTES = 128 * LROW;
constexpr int SMEM_BYTES = 4 * TILE_BYTES;

struct PlainLoad {
  const bf16* base;
  int ld;
  DI u32x4 operator()(int row, int k) const { return *(const u32x4*)(base + (size_t)row * ld + k); }
};

template <int MB, int NB, class AL, class BL>
DI void mainloop(f32x16 (&acc)[MB][NB], const AL& al, const BL& bl, int K, char* smem, int arow0, int brow0) {
  const int tid = tidx(), lane = tid & 63, r31 = lane & 31, hh = lane >> 5;
#pragma unroll
  for (int a = 0; a < MB; ++a)
#pragma unroll
    for (int b = 0; b < NB; ++b)
#pragma unroll
      for (int i = 0; i < 16; ++i) acc[a][b][i] = 0.f;
  u32x4 ra[4], rb[4];
  const int KT = K / BK;
#pragma unroll
  for (int i = 0; i < 4; ++i) { const int c = tid + 256 * i; ra[i] = al(c >> 3, (c & 7) * 8); rb[i] = bl(c >> 3, (c & 7) * 8); }
#pragma unroll
  for (int i = 0; i < 4; ++i) {
    const int c = tid + 256 * i;
    *(u32x4*)(smem + (c >> 3) * LROW + (c & 7) * 16) = ra[i];
    *(u32x4*)(smem + 2 * TILE_BYTES + (c >> 3) * LROW + (c & 7) * 16) = rb[i];
  }
  __syncthreads();
  for (int kt = 0; kt < KT; ++kt) {
    const int buf = kt & 1;
    if (kt + 1 < KT) {
#pragma unroll
      for (int i = 0; i < 4; ++i) { const int c = tid + 256 * i; ra[i] = al(c >> 3, (kt + 1) * BK + (c & 7) * 8); rb[i] = bl(c >> 3, (kt + 1) * BK + (c & 7) * 8); }
    }
    const char* sa = smem + buf * TILE_BYTES + (arow0 + r31) * LROW + hh * 16;
    const char* sb = smem + (2 + buf) * TILE_BYTES + (brow0 + r31) * LROW + hh * 16;
#pragma unroll
    for (int s = 0; s < 4; ++s) {
      bf16x8 af[MB], bfv[NB];
#pragma unroll
      for (int a = 0; a < MB; ++a) af[a] = *(const bf16x8*)(sa + a * 32 * LROW + s * 32);
#pragma unroll
      for (int b = 0; b < NB; ++b) bfv[b] = *(const bf16x8*)(sb + b * 32 * LROW + s * 32);
#pragma unroll
      for (int a = 0; a < MB; ++a)
#pragma unroll
        for (int b = 0; b < NB; ++b) acc[a][b] = MFMA32(af[a], bfv[b], acc[a][b]);
    }
    if (kt + 1 < KT) {
#pragma unroll
      for (int i = 0; i < 4; ++i) {
        const int c = tid + 256 * i;
        *(u32x4*)(smem + (buf ^ 1) * TILE_BYTES + (c >> 3) * LROW + (c & 7) * 16) = ra[i];
        *(u32x4*)(smem + (2 + (buf ^ 1)) * TILE_BYTES + (c >> 3) * LROW + (c & 7) * 16) = rb[i];
      }
    }
    __syncthreads();
  }
}

DI int glu_perm(int n) { return n < 1024 ? ((n >> 5) * 64 + (n & 31)) : (((n - 1024) >> 5) * 64 + 32 + ((n - 1024) & 31)); }

DI void conv_transpose_tile(const float* src, int N, bf16* dst, int tk, int tn, bool perm, char* smem) {
  bf16* T = (bf16*)smem;
  const int tid = tidx();
  __syncthreads();
#pragma unroll
  for (int ps = 0; ps < 4; ++ps) {
    const int r = ps * 16 + (tid >> 4), c4 = (tid & 15) * 4;
    const f32x4 v = *(const f32x4*)(src + (size_t)(tk * 64 + r) * N + tn * 64 + c4);
#pragma unroll
    for (int e = 0; e < 4; ++e) T[(c4 + e) * 66 + r] = f2bf(v[e]);
  }
  __syncthreads();
  const int c = tid >> 2, seg = tid & 3;
  int n = tn * 64 + c;
  if (perm) n = glu_perm(n);
  unsigned w[8];
#pragma unroll
  for (int e = 0; e < 8; ++e) w[e] = (unsigned)T[c * 66 + seg * 16 + 2 * e] | ((unsigned)T[c * 66 + seg * 16 + 2 * e + 1] << 16);
  bf16* d = dst + (size_t)n * 1024 + tk * 64 + seg * 16;
  *(u32x4*)d = u32x4{w[0], w[1], w[2], w[3]};
  *(u32x4*)(d + 8) = u32x4{w[4], w[5], w[6], w[7]};
}

DI void conv_elem(const float* src, bf16* dst, size_t base) {
  const size_t e = base + (size_t)tidx() * 8;
  const f32x4 a = *(const f32x4*)(src + e), b = *(const f32x4*)(src + e + 4);
  *(u32x4*)(dst + e) = u32x4{pack_bf16(a[0], a[1]), pack_bf16(a[2], a[3]), pack_bf16(b[0], b[1]), pack_bf16(b[2], b[3])};
}

constexpr float PEER_SU = 64.f, PEER_SV = 13.f;
DI unsigned enc_fp4(float x, float sc) {
  const float a = fabsf(x * sc);
  const unsigned code = (unsigned)(a >= 0.25f) + (unsigned)(a >= 0.75f) + (unsigned)(a >= 1.25f) + (unsigned)(a >= 1.75f) +
                        (unsigned)(a >= 2.5f) + (unsigned)(a >= 3.5f) + (unsigned)(a >= 5.f);
  return code | (x < 0.f ? 8u : 0u);
}
DI void conv_elem_fp4(const float* src, unsigned char* dst, size_t base, float sc) {
  const size_t e = base + (size_t)tidx() * 32;
  const size_t le = e >> 10, col = e & 1023;
  unsigned dw[4] = {0u, 0u, 0u, 0u};
#pragma unroll
  for (int q4 = 0; q4 < 8; ++q4) {
    const f32x4 v = *(const f32x4*)(src + e + 4 * q4);
#pragma unroll
    for (int t = 0; t < 4; ++t) { const int k = 4 * q4 + t; dw[k >> 3] |= enc_fp4(v[t], sc) << (4 * (k & 7)); }
  }
  unsigned char* p = dst + (((le >> 14) * 4 + (col >> 8)) * 16384 + (le & 16383)) * 128 + ((col & 255) >> 1);
  *(u32x4*)p = u32x4{dw[0], dw[1], dw[2], dw[3]};
}
DI unsigned pack4_fp8(float a, float b, float c, float d, float sc) {
  a = fminf(fmaxf(a * sc, -448.f), 448.f); b = fminf(fmaxf(b * sc, -448.f), 448.f);
  c = fminf(fmaxf(c * sc, -448.f), 448.f); d = fminf(fmaxf(d * sc, -448.f), 448.f);
  int p = 0;
  p = __builtin_amdgcn_cvt_pk_fp8_f32(a, b, p, false);
  p = __builtin_amdgcn_cvt_pk_fp8_f32(c, d, p, true);
  return (unsigned)p;
}
DI void conv_elem_fp8(const float* src, unsigned char* dst, size_t base, float sc) {
  const size_t e = base + (size_t)tidx() * 16;
  const size_t le = e >> 10, col = e & 1023;
  const size_t de = (((le >> 14) * 8 + (col >> 7)) * 16384 + (le & 16383)) * 128 + (col & 127);
  const f32x4 a = *(const f32x4*)(src + e), b = *(const f32x4*)(src + e + 4), c = *(const f32x4*)(src + e + 8), d = *(const f32x4*)(src + e + 12);
  *(u32x4*)(dst + de) = u32x4{pack4_fp8(a[0], a[1], a[2], a[3], sc), pack4_fp8(b[0], b[1], b[2], b[3], sc), pack4_fp8(c[0], c[1], c[2], c[3], sc), pack4_fp8(d[0], d[1], d[2], d[3], sc)};
}

DI void conv_phase(const Params& P, char* smem) {
  const int tid = tidx();
  constexpr int N_MOD = 384, N_TR = 5376, N_EL = 512 + 16384 + 2048;
  for (int item = blockIdx.x; item < N_MOD + N_TR + N_EL + 1; item += gridDim.x) {
    if (item < N_MOD) {
      const int layer = item / 96, cgp = item % 96;
      float* ssilu = (float*)smem;
      float* red = (float*)(smem + 36864);
      __syncthreads();
      for (int o = tid; o < 9 * 1024; o += 256) {
        const int cc = o >> 10, k = o & 1023;
        const float v = cc == 0 ? P.c_ctx[k] : P.c[(cc - 1) * 1024 + k];
        ssilu[o] = v / (1.f + __expf(-v));
      }
      __syncthreads();
      const int kq = tid >> 6, n = tid & 63;
      float acc[9];
#pragma unroll
      for (int cc = 0; cc < 9; ++cc) acc[cc] = 0.f;
      const float* wp = P.w_mod + ((size_t)layer * 1024 + kq * 256) * 6144 + cgp * 64 + n;
#pragma unroll 16
      for (int k = 0; k < 256; ++k) {
        const float w = wp[(size_t)k * 6144];
#pragma unroll
        for (int cc = 0; cc < 9; ++cc) acc[cc] += ssilu[cc * 1024 + kq * 256 + k] * w;
      }
#pragma unroll
      for (int cc = 0; cc < 9; ++cc) red[(kq * 9 + cc) * 64 + n] = acc[cc];
      __syncthreads();
      for (int o = tid; o < 576; o += 256) {
        const int cc = o >> 6, nn = o & 63;
        const float s = red[(0 * 9 + cc) * 64 + nn] + red[(1 * 9 + cc) * 64 + nn] + red[(2 * 9 + cc) * 64 + nn] + red[(3 * 9 + cc) * 64 + nn];
        ((float*)(P.ws + WS_MOD))[((size_t)layer * 9 + cc) * 6144 + cgp * 64 + nn] = s + P.b_mod[layer * 6144 + cgp * 64 + nn];
      }
    } else if (item < N_MOD + N_TR) {
      int t = item - N_MOD;
      const float* src; bf16* dst; int N; bool perm = false;
      if (t < 512) { const int j = t >> 8; t &= 255; src = P.ssm_w_in + (size_t)j * 1048576; dst = (bf16*)(P.ws + WS_WIN) + (size_t)j * 1048576; N = 1024; }
      else if (t < 1536) { t -= 512; const int j = t >> 9; t &= 511; src = P.ssm_w_glu + (size_t)j * 2097152; dst = (bf16*)(P.ws + WS_WGLU) + (size_t)j * 2097152; N = 2048; perm = true; }
      else if (t < 2048) { t -= 1536; const int j = t >> 8; t &= 255; src = P.ssm_w_out + (size_t)j * 1048576; dst = (bf16*)(P.ws + WS_WOUT) + (size_t)j * 1048576; N = 1024; }
      else if (t < 2816) { t -= 2048; const int j = t / 384; t %= 384; src = P.attn_w_qkv + (size_t)j * 1572864; dst = (bf16*)(P.ws + WS_WQKV) + (size_t)j * 1572864; N = 1536; }
      else if (t < 3328) { t -= 2816; const int j = t >> 8; t &= 255; src = P.attn_w_out + (size_t)j * 1048576; dst = (bf16*)(P.ws + WS_AWOUT) + (size_t)j * 1048576; N = 1024; }
      else { t -= 3328; const int j = t >> 9; t &= 511; src = P.peer_w_q + (size_t)j * 2097152; dst = (bf16*)(P.ws + WS_WQ) + (size_t)j * 2097152; N = 2048; }
      const int ntn = N / 64;
      conv_transpose_tile(src, N, dst, t / ntn, t % ntn, perm, smem);
    } else if (item < N_MOD + N_TR + N_EL) {
      int t = item - N_MOD - N_TR;
      if (t < 512) conv_elem(P.peer_keys, (bf16*)(P.ws + WS_KEYS), (size_t)t * 2048);
      else if (t < 512 + 8192) conv_elem_fp4(P.peer_u, (unsigned char*)(P.ws + WS_PU), (size_t)(t - 512) * 8192, PEER_SU);
      else if (t < 512 + 16384) conv_elem_fp4(P.peer_v, (unsigned char*)(P.ws + WS_PV), (size_t)(t - 512 - 8192) * 8192, PEER_SV);
      else if (t < 512 + 16384 + 1024) conv_elem(P.cache_k, (bf16*)(P.ws + WS_CK), (size_t)(t - 512 - 16384) * 2048);
      else conv_elem(P.cache_v, (bf16*)(P.ws + WS_CV), (size_t)(t - 512 - 16384 - 1024) * 2048);
    } else {
      float* rt = (float*)(P.ws + WS_ROPE);
      for (int o = tid; o < 1024; o += 256) {
        const int pos = o >> 4, f = o & 15;
        const float inv = powf(10000.f, -(float)f / 16.f);
        const float ang = (float)pos * inv;
        rt[o] = cosf(ang);
        rt[1024 + o] = sinf(ang);
      }
    }
  }
}

DI void prep_phase(const Params& P) {
  const float* mod = (const float*)(P.ws + WS_MOD);
  float* x = (float*)(P.ws + WS_X);
  bf16* h = (bf16*)(P.ws + WS_H);
  const size_t nvec = (size_t)NTOK * D / 8;
  for (size_t v = (size_t)blockIdx.x * 256 + tidx(); v < nvec; v += (size_t)gridDim.x * 256) {
    const int tok = (int)(v >> 7), col = (int)(v & 127) * 8;
    const float* src = tok < NCTX ? P.x_prompt + (size_t)tok * D + col : P.x_sample + (size_t)(tok - NCTX) * D + col;
    const f32x4 a = *(const f32x4*)src, b = *(const f32x4*)(src + 4);
    *(f32x4*)(x + (size_t)tok * D + col) = a;
    *(f32x4*)(x + (size_t)tok * D + col + 4) = b;
    const float* m = mod + (size_t)cond_of(tok) * 6144;
    const f32x4 sh0 = *(const f32x4*)(m + col), sh1 = *(const f32x4*)(m + col + 4);
    const f32x4 sc0 = *(const f32x4*)(m + 1024 + col), sc1 = *(const f32x4*)(m + 1024 + col + 4);
    float r[8];
#pragma unroll
    for (int e = 0; e < 4; ++e) { r[e] = a[e] * (1.f + sc0[e]) + sh0[e]; r[4 + e] = b[e] * (1.f + sc1[e]) + sh1[e]; }
    *(u32x4*)(h + (size_t)tok * D + col) = u32x4{pack_bf16(r[0], r[1]), pack_bf16(r[2], r[3]), pack_bf16(r[4], r[5]), pack_bf16(r[6], r[7])};
  }
}

template <class ALF, class EPI>
DI void gemm_phase(int N, const ALF& alf, const bf16* Bt, const EPI& epi, char* smem) {
  const int wv = tidx() >> 6;
  const int wm = wv >> 1, wn = wv & 1;
  const int ntn = N / 128;
  const int xcd = blockIdx.x & 7, lb = blockIdx.x >> 3, nlb = (gridDim.x + 7 - xcd) >> 3;
  const int ntx = ((NTOK / 128) - xcd + 7) >> 3;
  for (int t = lb; t < ntx * ntn; t += nlb) {
    const int tm = xcd + 8 * (t / ntn), tn = t % ntn;
    f32x16 acc[2][2];
    auto al = alf(tm * 128);
    PlainLoad bl{Bt + (size_t)tn * 128 * 1024, 1024};
    mainloop<2, 2>(acc, al, bl, 1024, smem, wm * 64, wn * 64);
    epi(acc, tm * 128 + wm * 64, tn * 128 + wn * 64);
    __syncthreads();
  }
}

struct PlainALF {
  const bf16* A;
  DI PlainLoad operator()(int m0) const { return PlainLoad{A + (size_t)m0 * 1024, 1024}; }
};

struct CombLoad {
  const bf16 *yf, *yb, *u;
  const float* d;
  DI u32x4 operator()(int row, int k) const {
    const size_t o = (size_t)row * 1024 + k;
    const u32x4 a = *(const u32x4*)(yf + o), b = *(const u32x4*)(yb + o), c = *(const u32x4*)(u + o);
    const f32x4 d0 = *(const f32x4*)(d + k), d1 = *(const f32x4*)(d + k + 4);
    unsigned r[4];
#pragma unroll
    for (int e = 0; e < 4; ++e) {
      const float dl = e < 2 ? d0[2 * e] : d1[2 * e - 4], dh = e < 2 ? d0[2 * e + 1] : d1[2 * e - 3];
      const float lo = bf_lo(a[e]) + bf_lo(b[e]) + dl * bf_lo(c[e]);
      const float hi = bf_hi(a[e]) + bf_hi(b[e]) + dh * bf_hi(c[e]);
      r[e] = pack_bf16(gelu_tanh(lo), gelu_tanh(hi));
    }
    return u32x4{r[0], r[1], r[2], r[3]};
  }
};
struct CombALF {
  const bf16 *yf, *yb, *u;
  const float* d;
  DI CombLoad operator()(int m0) const { const size_t o = (size_t)m0 * 1024; return CombLoad{yf + o, yb + o, u + o, d}; }
};

DI void comb_phase(const Params& P, int j) {
  bf16* yf = (bf16*)(P.ws + WS_YF);
  const bf16* yb = (const bf16*)(P.ws + WS_YB);
  const bf16* u = (const bf16*)(P.ws + WS_U);
  const float* d = P.ssm_d + (size_t)j * 1024;
  const size_t nvec = (size_t)NTOK * D / 8;
  for (size_t v = (size_t)blockIdx.x * 256 + tidx(); v < nvec; v += (size_t)gridDim.x * 256) {
    const int k = (int)(v & 127) * 8;
    const u32x4 a = *(const u32x4*)(yf + v * 8), b = *(const u32x4*)(yb + v * 8), c = *(const u32x4*)(u + v * 8);
    const f32x4 d0 = *(const f32x4*)(d + k), d1 = *(const f32x4*)(d + k + 4);
    unsigned r[4];
#pragma unroll
    for (int e = 0; e < 4; ++e) {
      const float dl = e < 2 ? d0[2 * e] : d1[2 * e - 4], dh = e < 2 ? d0[2 * e + 1] : d1[2 * e - 3];
      const float lo = bf_lo(a[e]) + bf_lo(b[e]) + dl * bf_lo(c[e]);
      const float hi = bf_hi(a[e]) + bf_hi(b[e]) + dh * bf_hi(c[e]);
      r[e] = pack_bf16(gelu_tanh(lo), gelu_tanh(hi));
    }
    *(u32x4*)(yf + v * 8) = u32x4{r[0], r[1], r[2], r[3]};
  }
}

template <int DIR>
DI void scan_chunks(const bf16* ubuf, bf16* ybuf, float* bu, char* Hs, const bf16x8 (&bfrag)[4], const bf16x8 (&cfrag)[8],
                    float abr, float abi, float& hre, float& him, int tok0, int nchunks, int g) {
  const int lane = tidx() & 63, r31 = lane & 31, hh = lane >> 5;
  f32x16 zero;
#pragma unroll
  for (int i = 0; i < 16; ++i) zero[i] = 0.f;
  bf16x8 ua_next = *(const bf16x8*)(ubuf + (size_t)(tok0 + (DIR ? nchunks - 1 : 0) * 32 + r31) * 1024 + g * 16 + 8 * hh);
  for (int ci = 0; ci < nchunks; ++ci) {
    const int cidx = DIR ? nchunks - 1 - ci : ci;
    const int t0 = tok0 + cidx * 32;
    const bf16x8 ua = ua_next;
    if (ci + 1 < nchunks) {
      const int cn = DIR ? nchunks - 2 - ci : ci + 1;
      ua_next = *(const bf16x8*)(ubuf + (size_t)(tok0 + cn * 32 + r31) * 1024 + g * 16 + 8 * hh);
    }
    f32x16 acc[4];
#pragma unroll
    for (int blk = 0; blk < 4; ++blk) acc[blk] = MFMA32(ua, bfrag[blk], zero);
#pragma unroll
    for (int hf2 = 0; hf2 < 2; ++hf2) {
      constexpr int dsel = DIR;
      const int hf = dsel ? 1 - hf2 : hf2;
#pragma unroll
      for (int blk = 0; blk < 4; ++blk)
#pragma unroll
        for (int i = 0; i < 8; ++i) bu[crow(i, hh) * 128 + 32 * blk + r31] = acc[blk][8 * hf + i];
      wave_fence();
      fl2_t bvs[16];
#pragma unroll
      for (int s = 0; s < 16; ++s) bvs[s] = *(const fl2_t*)(bu + (DIR ? 15 - s : s) * 128 + 2 * lane);
      asm volatile("" ::: "memory");
#pragma unroll
      for (int s = 0; s < 16; ++s) {
        const int tl = DIR ? 15 - s : s;
        const fl2_t bv = bvs[s];
        float nre = __builtin_fmaf(abr, hre, __builtin_fmaf(-abi, him, bv[0]));
        asm volatile("" : "+v"(nre));
        float nim = __builtin_fmaf(abr, him, __builtin_fmaf(abi, hre, bv[1]));
        asm volatile("" : "+v"(nim));
        hre = nre; him = nim;
        *(unsigned*)(Hs + (hf * 16 + tl) * 272 + lane * 4) = pack_bf16(hre, him);
      }
      wave_fence();
    }
    f32x16 y = zero, y2 = zero;
#pragma unroll
    for (int s = 0; s < 8; s += 2) {
      const bf16x8 a = *(const bf16x8*)(Hs + r31 * 272 + s * 32 + hh * 16);
      const bf16x8 a2 = *(const bf16x8*)(Hs + r31 * 272 + (s + 1) * 32 + hh * 16);
      y = MFMA32(a, cfrag[s], y);
      y2 = MFMA32(a2, cfrag[s + 1], y2);
    }
    wave_fence();
    bf16* ys = (bf16*)bu;
    if (r31 < 16) {
#pragma unroll
      for (int i = 0; i < 16; ++i) ys[crow(i, hh) * 16 + r31] = f2bf(y[i] + y2[i]);
    }
    wave_fence();
    {
      const u32x4 w = *(const u32x4*)(ys + (lane >> 1) * 16 + (lane & 1) * 8);
      *(u32x4*)(ybuf + (size_t)(t0 + (lane >> 1)) * 1024 + g * 16 + (lane & 1) * 8) = w;
    }
    wave_fence();
  }
}

DI void scan_phase(const Params& P, int j, char* smem) {
  const int lane = tidx() & 63, wv = tidx() >> 6, r31 = lane & 31, hh = lane >> 5;

  float* bu = (float*)(smem + wv * 16896);
  char* Hs = smem + wv * 16896 + 8192;
  const bf16* ubuf = (const bf16*)(P.ws + WS_U);
  f32x16 zero;
#pragma unroll
  for (int i = 0; i < 16; ++i) zero[i] = 0.f;
  const bool split = gridDim.x >= 320;
  const int it0 = split ? (blockIdx.x < 256 ? (int)blockIdx.x : 256 + ((int)blockIdx.x - 256)) : (int)blockIdx.x;
  const int itstep = split ? (blockIdx.x < 256 ? 1 << 20 : (int)gridDim.x - 256) : (int)gridDim.x;
  for (int item = it0; item < 1280; item += itstep) {
    const bool lat = item < 256;
    const int cc = lat ? item : item - 256;
    const int dir = cc & 1, g = ((cc >> 1) & 15) * 4 + wv, b = cc >> 5;
    const int L = lat ? 4096 : 256;
    const int tok0 = lat ? NCTX + b * 4096 : b * 256;
    const int pidx = (j * 2 + dir) * 64 + g;
    const float dt = __expf(P.ssm_log_dt[pidx]);
    float abr, abi;
    {
      const float are = P.ssm_a_re[pidx * 64 + lane], aim = P.ssm_a_im[pidx * 64 + lane];
      const float mag = __expf(are * dt);
      float sn, cs;
      sincosf(aim * dt, &sn, &cs);
      abr = mag * cs; abi = mag * sn;
    }
    bf16x8 bfrag[4];
#pragma unroll
    for (int blk = 0; blk < 4; ++blk) {
      const int n = 32 * blk + r31, p = n >> 1, part = n & 1;
      const float are = P.ssm_a_re[pidx * 64 + p], aim = P.ssm_a_im[pidx * 64 + p];
      const float mag = __expf(are * dt);
      float sn, cs;
      sincosf(aim * dt, &sn, &cs);
      const float xr = mag * cs - 1.f, xi = mag * sn;
      const float den = 1.f / (are * are + aim * aim);
      const float cr = (xr * are + xi * aim) * den, ci = (xi * are - xr * aim) * den;
      const float* br = P.ssm_b_re + ((size_t)pidx * 64 + p) * 16 + 8 * hh;
      const float* bi = P.ssm_b_im + ((size_t)pidx * 64 + p) * 16 + 8 * hh;
      unsigned w[4];
#pragma unroll
      for (int e = 0; e < 4; ++e) {
        const float r0 = br[2 * e], i0 = bi[2 * e], r1 = br[2 * e + 1], i1 = bi[2 * e + 1];
        const float v0 = part ? (cr * i0 + ci * r0) : (cr * r0 - ci * i0);
        const float v1 = part ? (cr * i1 + ci * r1) : (cr * r1 - ci * i1);
        w[e] = pack_bf16(v0, v1);
      }
      bfrag[blk] = __builtin_bit_cast(bf16x8, u32x4{w[0], w[1], w[2], w[3]});
    }
    bf16x8 cfrag[8];
#pragma unroll
    for (int s = 0; s < 8; ++s) {
      unsigned w[4];
#pragma unroll
      for (int e = 0; e < 4; ++e) {
        const int p = 8 * s + 4 * hh + e;
        float v0 = 0.f, v1 = 0.f;
        if (r31 < 16) {
          v0 = P.ssm_c_re[((size_t)pidx * 16 + r31) * 64 + p];
          v1 = -P.ssm_c_im[((size_t)pidx * 16 + r31) * 64 + p];
        }
        w[e] = pack_bf16(v0, v1);
      }
      cfrag[s] = __builtin_bit_cast(bf16x8, u32x4{w[0], w[1], w[2], w[3]});
    }
    float hre = 0.f, him = 0.f;
    if (lat) {
      const size_t si = ((((size_t)b * 2 + j) * 2 + dir) * 64 + g) * 64 + lane;
      hre = P.st_re[si]; him = P.st_im[si];
    }
    bf16* ybuf = (bf16*)(P.ws + (dir ? WS_YB : WS_YF));
    const int nchunks = L / 32;
    if (dir) scan_chunks<1>(ubuf, ybuf, bu, Hs, bfrag, cfrag, abr, abi, hre, him, tok0, nchunks, g);
    else scan_chunks<0>(ubuf, ybuf, bu, Hs, bfrag, cfrag, abr, abi, hre, him, tok0, nchunks, g);
    if (!lat) {
      const size_t so = ((((size_t)b * 2 + j) * 2 + dir) * 64 + g) * 64 + lane;
      P.out[OUT_SRE + so] = hre;
      P.out[OUT_SIM + so] = him;
    }
  }
}

DI void attn_phase(const Params& P, int j, char* smem) {
  const int tid = tidx(), lane = tid & 63, wv = tid >> 6, r31 = lane & 31, hh = lane >> 5;
  char* Ks = smem;
  char* Vt = smem + 9216;
  const bf16* qbuf = (const bf16*)(P.ws + WS_U);
  const bf16* kbuf = (const bf16*)(P.ws + WS_YF);
  const bf16* vbuf = (const bf16*)(P.ws + WS_YB);
  const bf16* ck = (const bf16*)(P.ws + WS_CK);
  const bf16* cv = (const bf16*)(P.ws + WS_CV);
  bf16* zbuf = (bf16*)(P.ws + WS_Z);
  for (int item = blockIdx.x; item < 5120; item += gridDim.x) {
    const bool lat = item < 4096;
    int qb, head, b, tokq0;
    if (lat) { qb = item & 31; head = (item >> 5) & 15; b = item >> 9; tokq0 = NCTX + b * 4096 + qb * 128; }
    else { const int it = item - 4096; qb = it & 1; head = (it >> 1) & 15; b = it >> 5; tokq0 = b * 256 + qb * 128; }
    const int kvh = head >> 2;
    const int qtok = tokq0 + wv * 32 + r31;
    constexpr float QSC = 0.125f * 1.4426950408889634f;
    bf16x8 qf[4];
#pragma unroll
    for (int s = 0; s < 4; ++s) {
      const u32x4 qr = *(const u32x4*)(qbuf + (size_t)qtok * 1024 + head * 64 + 16 * s + 8 * hh);
      qf[s] = __builtin_bit_cast(bf16x8, u32x4{pack_bf16(bf_lo(qr[0]) * QSC, bf_hi(qr[0]) * QSC), pack_bf16(bf_lo(qr[1]) * QSC, bf_hi(qr[1]) * QSC),
                                                 pack_bf16(bf_lo(qr[2]) * QSC, bf_hi(qr[2]) * QSC), pack_bf16(bf_lo(qr[3]) * QSC, bf_hi(qr[3]) * QSC)});
    }
    float m = P.attn_sink[j * 16 + head] * 1.4426950408889634f;
    float lsum = hh == 0 ? 1.f : 0.f;
    f32x16 o[2];
#pragma unroll
    for (int i = 0; i < 16; ++i) { o[0][i] = 0.f; o[1][i] = 0.f; }
    int t_lo = 0, t_hi = 4;
    if (lat) {
      const int w0 = qb * 128 - 128;
      const int first = w0 < 0 ? 10 : 8;
      int last = 14;
      while (w0 + (last - 1 - 8) * 64 >= 4096) --last;
      t_lo = 0; t_hi = last;
      (void)first;
    }
    auto tile_info = [&](int tile, const bf16*& kb, const bf16*& vb, bool& masked, int& kpos0) -> bool {
      masked = false; kpos0 = 0;
      if (lat) {
        if (tile < 8) {
          const size_t off = (((size_t)b * 2 + j) * 512 + tile * 64) * 256 + kvh * 64;
          kb = ck + off; vb = cv + off;
        } else {
          kpos0 = qb * 128 - 128 + (tile - 8) * 64;
          if (kpos0 < 0 || kpos0 >= 4096) return false;
          masked = true;
          const size_t off = ((size_t)NCTX + b * 4096 + kpos0) * 256 + kvh * 64;
          kb = kbuf + off; vb = vbuf + off;
        }
      } else {
        const size_t off = ((size_t)b * 256 + tile * 64) * 256 + kvh * 64;
        kb = kbuf + off; vb = vbuf + off;
      }
      return true;
    };
    u32x4 pk[2], pv[2];
    auto prefetch = [&](int tile) {
      const bf16 *kb, *vb; bool mk; int kp;
      if (tile < t_hi && tile_info(tile, kb, vb, mk, kp)) {
#pragma unroll
        for (int i = 0; i < 2; ++i) {
          const int c = tid + 256 * i, key = c >> 3, dc = c & 7;
          pk[i] = *(const u32x4*)(kb + (size_t)key * 256 + dc * 8);
          pv[i] = *(const u32x4*)(vb + (size_t)key * 256 + dc * 8);
        }
      }
    };
    prefetch(t_lo);
    for (int tile = t_lo; tile < t_hi; ++tile) {
      const bf16 *kb, *vb;
      bool masked;
      int kpos0;
      if (!tile_info(tile, kb, vb, masked, kpos0)) { prefetch(tile + 1); continue; }
      __syncthreads();
#pragma unroll
      for (int i = 0; i < 2; ++i) {
        const int c = tid + 256 * i, key = c >> 3, dc = c & 7;
        const u32x4 kk = pk[i], vv = pv[i];
        *(u32x4*)(Ks + key * 144 + dc * 16) = kk;
#pragma unroll
        for (int e = 0; e < 4; ++e) {
          *(bf16*)(Vt + (dc * 8 + 2 * e) * 144 + key * 2) = (bf16)(vv[e] & 0xffffu);
          *(bf16*)(Vt + (dc * 8 + 2 * e + 1) * 144 + key * 2) = (bf16)(vv[e] >> 16);
        }
      }
      __syncthreads();
      prefetch(tile + 1);
      f32x16 sacc[2];
#pragma unroll
      for (int i = 0; i < 16; ++i) { sacc[0][i] = 0.f; sacc[1][i] = 0.f; }
#pragma unroll
      for (int mb = 0; mb < 2; ++mb)
#pragma unroll
        for (int s = 0; s < 4; ++s) {
          const bf16x8 a = *(const bf16x8*)(Ks + (mb * 32 + r31) * 144 + s * 32 + hh * 16);
          sacc[mb] = MFMA32(a, qf[s], sacc[mb]);
        }
      float mx = m;
      const int qp = qb * 128 + wv * 32 + r31;
#pragma unroll
      for (int mb = 0; mb < 2; ++mb)
#pragma unroll
        for (int i = 0; i < 16; ++i) {
          float v = sacc[mb][i];
          if (masked) {
            const int dlt = kpos0 + mb * 32 + crow(i, hh) - qp;
            v = (dlt >= -128 && dlt <= 128) ? v : -1e30f;
          }
          sacc[mb][i] = v;
          mx = fmaxf(mx, v);
        }
      mx = fmaxf(mx, __shfl_xor(mx, 32));
      const float alpha = __builtin_amdgcn_exp2f(m - mx);
      if (__builtin_amdgcn_ballot_w64(mx != m) != 0) {
        lsum *= alpha;
#pragma unroll
        for (int i = 0; i < 16; ++i) { o[0][i] *= alpha; o[1][i] *= alpha; }
      }
      m = mx;
#pragma unroll
      for (int mb = 0; mb < 2; ++mb)
#pragma unroll
        for (int i = 0; i < 16; ++i) { const float p = __builtin_amdgcn_exp2f(sacc[mb][i] - mx); sacc[mb][i] = p; lsum += p; }
#pragma unroll
      for (int mb = 0; mb < 2; ++mb)
#pragma unroll
        for (int s2 = 0; s2 < 2; ++s2) {
          const u32x4 pw = u32x4{pack_bf16(sacc[mb][8 * s2 + 0], sacc[mb][8 * s2 + 1]), pack_bf16(sacc[mb][8 * s2 + 2], sacc[mb][8 * s2 + 3]),
                                 pack_bf16(sacc[mb][8 * s2 + 4], sacc[mb][8 * s2 + 5]), pack_bf16(sacc[mb][8 * s2 + 6], sacc[mb][8 * s2 + 7])};
          const bf16x8 pf = __builtin_bit_cast(bf16x8, pw);
#pragma unroll
          for (int db = 0; db < 2; ++db) {
            const char* vp = Vt + (db * 32 + r31) * 144 + (mb * 32 + 16 * s2 + 4 * hh) * 2;
            const u32x2 lo = *(const u32x2*)vp, hi = *(const u32x2*)(vp + 16);
            const bf16x8 a = __builtin_bit_cast(bf16x8, u32x4{lo[0], lo[1], hi[0], hi[1]});
            o[db] = MFMA32(a, pf, o[db]);
          }
        }
    }
    const float ltot = lsum + __shfl_xor(lsum, 32);
    const float inv = 1.f / ltot;
#pragma unroll
    for (int db = 0; db < 2; ++db)
#pragma unroll
      for (int g4 = 0; g4 < 4; ++g4) {
        const u32x2 w = u32x2{pack_bf16(o[db][4 * g4] * inv, o[db][4 * g4 + 1] * inv), pack_bf16(o[db][4 * g4 + 2] * inv, o[db][4 * g4 + 3] * inv)};
        *(u32x2*)(zbuf + (size_t)qtok * 1024 + head * 64 + db * 32 + 8 * g4 + 4 * hh) = w;
      }
  }
}

DI void ln_phase(const Params& P, int layer, int which) {
  const int lane = tidx() & 63, wv = tidx() >> 6;
  const bool last = which == 1 && layer == DEPTH - 1;
  const float* mod = (const float*)(P.ws + WS_MOD) + (size_t)(layer + which) * 9 * 6144 + (which ? 0 : 3 * 1024);
  float* x = (float*)(P.ws + WS_X);
  bf16* h = (bf16*)(P.ws + WS_H);
  const float* lg = P.ln_g + (size_t)(layer * 2 + which) * 1024;
  const float* lb = P.ln_b + (size_t)(layer * 2 + which) * 1024;
  const int tstride = gridDim.x * 4;
  f32x4 nx[4];
  {
    const int t0 = blockIdx.x * 4 + wv;
    if (t0 < NTOK) {
#pragma unroll
      for (int c = 0; c < 4; ++c) nx[c] = *(const f32x4*)(x + (size_t)t0 * D + c * 256 + lane * 4);
    }
  }
  for (int tok = blockIdx.x * 4 + wv; tok < NTOK; tok += tstride) {
    float* xr = x + (size_t)tok * D;
    float v[16];
#pragma unroll
    for (int c = 0; c < 4; ++c) { const f32x4 t = nx[c]; v[4 * c] = t[0]; v[4 * c + 1] = t[1]; v[4 * c + 2] = t[2]; v[4 * c + 3] = t[3]; }
    if (tok + tstride < NTOK) {
#pragma unroll
      for (int c = 0; c < 4; ++c) nx[c] = *(const f32x4*)(x + (size_t)(tok + tstride) * D + c * 256 + lane * 4);
    }
    float s = 0.f;
#pragma unroll
    for (int e = 0; e < 16; ++e) s += v[e];
    const float mu = wave_sum(s) * (1.f / 1024.f);
    float q = 0.f;
#pragma unroll
    for (int e = 0; e < 16; ++e) { const float d = v[e] - mu; q += d * d; }
    const float rstd = rsqrtf(wave_sum(q) * (1.f / 1024.f) + LN_EPS);
    const float* m = mod + (size_t)cond_of(tok) * 6144;
#pragma unroll
    for (int c = 0; c < 4; ++c) {
      const int col = c * 256 + lane * 4;
      const f32x4 g4 = *(const f32x4*)(lg + col), b4 = *(const f32x4*)(lb + col);
      f32x4 y;
#pragma unroll
      for (int e = 0; e < 4; ++e) y[e] = (v[4 * c + e] - mu) * rstd * g4[e] + b4[e];
      if (last) { *(f32x4*)(P.out + OUT_Y + (size_t)tok * D + col) = y; continue; }
      const f32x4 sh = *(const f32x4*)(m + col), sc = *(const f32x4*)(m + 1024 + col);
      float hv[4];
#pragma unroll
      for (int e = 0; e < 4; ++e) hv[e] = y[e] * (1.f + sc[e]) + sh[e];
      *(f32x4*)(xr + col) = y;
      *(u32x2*)(h + (size_t)tok * D + col) = u32x2{pack_bf16(hv[0], hv[1]), pack_bf16(hv[2], hv[3])};
    }
  }
}

DI void route_phase(const Params& P, int layer, char* smem) {
  const int tid = tidx(), lane = tid & 63, wv = tid >> 6, r31 = lane & 31, hh = lane >> 5;
  const bf16* hbuf = (const bf16*)(P.ws + WS_H);
  const bf16* wq = (const bf16*)(P.ws + WS_WQ) + (size_t)layer * 2097152;
  const bf16* keys = (const bf16*)(P.ws + WS_KEYS);
  int* idxo = (int*)(P.ws + WS_IDX);
  float* go = (float*)(P.ws + WS_G);
  f32x16 zero;
#pragma unroll
  for (int i = 0; i < 16; ++i) zero[i] = 0.f;
  const int xcd = blockIdx.x & 7, lb = blockIdx.x >> 3, nlb = (gridDim.x + 7 - xcd) >> 3;
  const int ntx = (320 - xcd + 7) >> 3;
  for (int item = lb; item < ntx * 8; item += nlb) {
    const int tm = xcd + 8 * (item >> 3), head = item & 7;
    const int hmask = -hh;
    int t1[16], t2[16];
    for (int half = 0; half < 2; ++half) {
      f32x16 acc[4][1];
      PlainLoad al{wq + ((size_t)head * 256 + half * 128) * 1024, 1024};
      PlainLoad bl{hbuf + (size_t)tm * 128 * 1024, 1024};
      const bf16* kbase = keys + ((((size_t)layer * 2 + half) * 8 + head) * 128) * 128;
      u32x4 kreg[8];
#pragma unroll
      for (int i = 0; i < 8; ++i) { const int c = tid + 256 * i; kreg[i] = *(const u32x4*)(kbase + (size_t)(c >> 4) * 128 + (c & 15) * 8); }
      mainloop<4, 1>(acc, al, bl, 1024, smem, 0, wv * 32);
#pragma unroll
      for (int i = 0; i < 8; ++i) { const int c = tid + 256 * i; *(u32x4*)(smem + (c >> 4) * 272 + (c & 15) * 16) = kreg[i]; }
      __syncthreads();
      bf16x8 qf[4][2];
#pragma unroll
      for (int mb = 0; mb < 4; ++mb)
#pragma unroll
        for (int s2 = 0; s2 < 2; ++s2) {
          const f32x16& a = acc[mb][0];
          qf[mb][s2] = __builtin_bit_cast(bf16x8, u32x4{pack_bf16(a[8 * s2 + 0], a[8 * s2 + 1]), pack_bf16(a[8 * s2 + 2], a[8 * s2 + 3]),
                                                         pack_bf16(a[8 * s2 + 4], a[8 * s2 + 5]), pack_bf16(a[8 * s2 + 6], a[8 * s2 + 7])});
        }
      int v[64];
#pragma unroll
      for (int kb = 0; kb < 4; ++kb) {
        f32x16 sc = zero;
#pragma unroll
        for (int mb = 0; mb < 4; ++mb)
#pragma unroll
          for (int s2 = 0; s2 < 2; ++s2) {
            const char* kp = smem + (kb * 32 + r31) * 272 + (mb * 32 + 16 * s2 + 4 * hh) * 2;
            const u32x2 lo = *(const u32x2*)kp, hi = *(const u32x2*)(kp + 16);
            const bf16x8 a = __builtin_bit_cast(bf16x8, u32x4{lo[0], lo[1], hi[0], hi[1]});
            sc = MFMA32(a, qf[mb][s2], sc);
          }
#pragma unroll
        for (int i = 0; i < 16; ++i) {
          const int key = kb * 32 + crow(i, hh);
          v[kb * 16 + i] = f2key(__int_as_float((__float_as_int(sc[i]) & ~0x7f) | key));
        }
      }
      __syncthreads();
      sort16_desc<64, 0>(v); sort16_desc<64, 16>(v); sort16_desc<64, 32>(v); sort16_desc<64, 48>(v);
      merge16_desc<64, 0, 16>(v); merge16_desc<64, 32, 48>(v); merge16_desc<64, 0, 32>(v);
      pair_merge16<64>(v);
      if (half == 0) {
#pragma unroll
        for (int i = 0; i < 16; ++i) t1[i] = key2bits(v[i]);
      } else {
#pragma unroll
        for (int i = 0; i < 16; ++i) t2[i] = key2bits(v[i]);
      }
    }
    int cd[32];
    {
      int ce[25], co[25];
      int cnt = 0;
#pragma unroll
      for (int a = 0; a < 16; ++a)
#pragma unroll
        for (int bq = 0; bq < 16; ++bq) {
          if ((a + 1) * (bq + 1) <= 16) {
            const float sum = __int_as_float(t1[a] & ~0x7f) + __int_as_float(t2[bq] & ~0x7f);
            const int kk = f2key(__int_as_float((__float_as_int(sum) & ~0xff) | (a * 16 + bq)));
            if ((cnt & 1) == 0) ce[cnt >> 1] = kk; else co[cnt >> 1] = kk;
            ++cnt;
          }
        }
#pragma unroll
      for (int s = 0; s < 25; ++s) cd[s] = bsel(hmask, ce[s], co[s]);
#pragma unroll
      for (int s = 25; s < 32; ++s) cd[s] = (int)0x80000000;
    }
    sort16_desc<32, 0>(cd); sort16_desc<32, 16>(cd);
    merge16_desc<32, 0, 16>(cd);
    pair_merge16<32>(cd);
    unsigned char* tab = (unsigned char*)smem + wv * 1024;
    {
      unsigned w[4];
#pragma unroll
      for (int e = 0; e < 4; ++e) {
        const unsigned b0 = (unsigned)(bsel(hmask, t1[4 * e], t2[4 * e]) & 0x7f), b1 = (unsigned)(bsel(hmask, t1[4 * e + 1], t2[4 * e + 1]) & 0x7f);
        const unsigned b2 = (unsigned)(bsel(hmask, t1[4 * e + 2], t2[4 * e + 2]) & 0x7f), b3 = (unsigned)(bsel(hmask, t1[4 * e + 3], t2[4 * e + 3]) & 0x7f);
        w[e] = b0 | (b1 << 8) | (b2 << 16) | (b3 << 24);
      }
      *(u32x4*)(tab + r31 * 32 + hh * 16) = u32x4{w[0], w[1], w[2], w[3]};
    }
    wave_fence();
    float vals[16]; int eidx[16];
    float ssum = 0.f;
    const float v0 = __int_as_float(key2bits(cd[0]) & ~0xff);
#pragma unroll
    for (int r = 0; r < 16; ++r) {
      const int bits = key2bits(cd[r]);
      const int code = bits & 0xff;
      const int i1 = tab[r31 * 32 + (code >> 4)], i2 = tab[r31 * 32 + 16 + (code & 15)];
      eidx[r] = i1 * 128 + i2;
      vals[r] = __expf(__int_as_float(bits & ~0xff) - v0);
      ssum += vals[r];
    }
    const float inv = 1.f / ssum;
    const int tok = tm * 128 + wv * 32 + r31;
    int ei[8]; float gv[8];
#pragma unroll
    for (int r = 0; r < 8; ++r) { ei[r] = bsel(hmask, eidx[r], eidx[8 + r]); gv[r] = __int_as_float(bsel(hmask, __float_as_int(vals[r]), __float_as_int(vals[8 + r]))) * inv; }
    const size_t ob = ((size_t)tok * 8 + head) * 16 + 8 * hh;
    *(u32x4*)(idxo + ob) = u32x4{(unsigned)ei[0], (unsigned)ei[1], (unsigned)ei[2], (unsigned)ei[3]};
    *(u32x4*)(idxo + ob + 4) = u32x4{(unsigned)ei[4], (unsigned)ei[5], (unsigned)ei[6], (unsigned)ei[7]};
    *(f32x4*)(go + ob) = f32x4{gv[0], gv[1], gv[2], gv[3]};
    *(f32x4*)(go + ob + 4) = f32x4{gv[4], gv[5], gv[6], gv[7]};
    __syncthreads();
  }
}

DI float dpp_f(float x, const int ctrl_sel) {
  const int xi = __float_as_int(x);
  int r;
  if (ctrl_sel == 0) r = __builtin_amdgcn_update_dpp(0, xi, 0xB1, 0xf, 0xf, false);
  else if (ctrl_sel == 1) r = __builtin_amdgcn_update_dpp(0, xi, 0x4E, 0xf, 0xf, false);
  else if (ctrl_sel == 2) r = __builtin_amdgcn_update_dpp(0, xi, 0x141, 0xf, 0xf, false);
  else r = __builtin_amdgcn_update_dpp(0, xi, 0x140, 0xf, 0xf, false);
  return __int_as_float(r);
}
DI float row16_sum(float s) { s += dpp_f(s, 0); s += dpp_f(s, 1); s += dpp_f(s, 2); s += dpp_f(s, 3); return s; }

DI float row8_sum(float s) { s += dpp_f(s, 0); s += dpp_f(s, 1); s += dpp_f(s, 2); return s; }
DI float ror8_add(float x) { return x + __int_as_float(__builtin_amdgcn_update_dpp(0, __float_as_int(x), 0x128, 0xf, 0xf, false)); }

DI fl2_t dec4(unsigned w, int b) {
  if (b == 0) return __builtin_amdgcn_cvt_scalef32_pk_f32_fp4(w, 1.0f, 0);
  if (b == 1) return __builtin_amdgcn_cvt_scalef32_pk_f32_fp4(w, 1.0f, 1);
  if (b == 2) return __builtin_amdgcn_cvt_scalef32_pk_f32_fp4(w, 1.0f, 2);
  return __builtin_amdgcn_cvt_scalef32_pk_f32_fp4(w, 1.0f, 3);
}
constexpr float PEER_HS = 2.f;
typedef __attribute__((ext_vector_type(8))) int i32x8;
struct UAux { u32x4 h; float p0, p1, g0, g1; };
DI void gatherU_phase(const Params& P, int layer, char* smem) {
  const int lane = tidx() & 63, wv = tidx() >> 6, rg = lane >> 3, cl = lane & 7, r16 = lane & 15, q = lane >> 4;
  const bf16* h = (const bf16*)(P.ws + WS_H);
  const unsigned char* ut = (const unsigned char*)(P.ws + WS_PU) + (size_t)layer * 4 * 16384 * 128;
  const int* idx = (const int*)(P.ws + WS_IDX);
  const float* gg = (const float*)(P.ws + WS_G);
  float* act = (float*)(P.ws + WS_ACT);
  char* T = smem + wv * 18432;
  int* s_idx = (int*)(smem + wv * 18432 + 17408);
  float* s_part = (float*)(smem + wv * 18432 + 17920);
  const int gw = blockIdx.x * 4 + wv, nw = gridDim.x * 4;
  const int K = gw < NTOK ? (NTOK - 1 - gw) / nw + 1 : 0;
  for (int c = 0; c < 4; ++c) {
    const unsigned char* uts = ut + (size_t)c * 16384 * 128 + cl * 16;
    auto load_idx = [&](int tok, int& i0, int& i1) { i0 = idx[(size_t)tok * 128 + lane]; i1 = idx[(size_t)tok * 128 + 64 + lane]; };
    auto load_aux = [&](UAux& ax, int tok) {
      ax.h = *(const u32x4*)(h + (size_t)tok * D + c * 256 + ((r16 & 7) >> 2) * 128 + q * 32 + (r16 & 3) * 8);
      ax.p0 = 0.f; ax.p1 = 0.f; ax.g0 = 0.f; ax.g1 = 0.f;
      if (c > 0) {
        ax.p0 = __hip_atomic_load(act + (size_t)tok * 128 + lane, __ATOMIC_RELAXED, __HIP_MEMORY_SCOPE_AGENT);
        ax.p1 = __hip_atomic_load(act + (size_t)tok * 128 + 64 + lane, __ATOMIC_RELAXED, __HIP_MEMORY_SCOPE_AGENT);
      }
      if (c == 3) { ax.g0 = gg[(size_t)tok * 128 + lane]; ax.g1 = gg[(size_t)tok * 128 + 64 + lane]; }
    };
    auto compute = [&](const u32x4(&rows)[16], const UAux& ax, int tok) {
      i32x8 hb1[2], hb2[2];
      {
        const u32x4 hv = ax.h;
        unsigned w1 = 0, w2 = 0;
#pragma unroll
        for (int e = 0; e < 4; ++e) {
          const float f0 = bf_lo(hv[e]) * PEER_HS, f1 = bf_hi(hv[e]) * PEER_HS;
          if (e == 0) w1 = __builtin_amdgcn_cvt_scalef32_pk_fp4_f32(w1, f0, f1, 1.0f, 0);
          else if (e == 1) w1 = __builtin_amdgcn_cvt_scalef32_pk_fp4_f32(w1, f0, f1, 1.0f, 1);
          else if (e == 2) w1 = __builtin_amdgcn_cvt_scalef32_pk_fp4_f32(w1, f0, f1, 1.0f, 2);
          else w1 = __builtin_amdgcn_cvt_scalef32_pk_fp4_f32(w1, f0, f1, 1.0f, 3);
        }
#pragma unroll
        for (int e = 0; e < 4; ++e) {
          const fl2_t d = dec4(w1, e);
          const float r0 = (bf_lo(hv[e]) * PEER_HS - d[0]) * 4.f, r1 = (bf_hi(hv[e]) * PEER_HS - d[1]) * 4.f;
          if (e == 0) w2 = __builtin_amdgcn_cvt_scalef32_pk_fp4_f32(w2, r0, r1, 1.0f, 0);
          else if (e == 1) w2 = __builtin_amdgcn_cvt_scalef32_pk_fp4_f32(w2, r0, r1, 1.0f, 1);
          else if (e == 2) w2 = __builtin_amdgcn_cvt_scalef32_pk_fp4_f32(w2, r0, r1, 1.0f, 2);
          else w2 = __builtin_amdgcn_cvt_scalef32_pk_fp4_f32(w2, r0, r1, 1.0f, 3);
        }
        unsigned* s_h = (unsigned*)s_idx;
        wave_fence();
        s_h[q * 16 + r16] = r16 < 8 ? w1 : w2;
        wave_fence();
        const u32x4 a0 = *(const u32x4*)(s_h + q * 16), a1 = *(const u32x4*)(s_h + q * 16 + 4);
        const u32x4 b0 = *(const u32x4*)(s_h + q * 16 + 8), b1 = *(const u32x4*)(s_h + q * 16 + 12);
        hb1[0] = i32x8{(int)a0[0], (int)a0[1], (int)a0[2], (int)a0[3], 0, 0, 0, 0};
        hb1[1] = i32x8{(int)a1[0], (int)a1[1], (int)a1[2], (int)a1[3], 0, 0, 0, 0};
        hb2[0] = i32x8{(int)b0[0], (int)b0[1], (int)b0[2], (int)b0[3], 0, 0, 0, 0};
        hb2[1] = i32x8{(int)b1[0], (int)b1[1], (int)b1[2], (int)b1[3], 0, 0, 0, 0};
      }
      wave_fence();
#pragma unroll
      for (int rb = 0; rb < 16; ++rb) {
        char* tp = T + (rb * 8 + rg) * 136 + cl * 16;
        *(u32x2*)tp = u32x2{rows[rb][0], rows[rb][1]};
        *(u32x2*)(tp + 8) = u32x2{rows[rb][2], rows[rb][3]};
      }
      wave_fence();
#pragma unroll
      for (int mt = 0; mt < 8; ++mt) {
        f32x4 acc = {0.f, 0.f, 0.f, 0.f};
#pragma unroll
        for (int s2 = 0; s2 < 2; ++s2) {
          const char* tp = T + (mt * 16 + r16) * 136 + s2 * 64 + q * 16;
          const u32x2 lo = *(const u32x2*)tp, hi = *(const u32x2*)(tp + 8);
          const i32x8 av = {(int)lo[0], (int)lo[1], (int)hi[0], (int)hi[1], 0, 0, 0, 0};
          acc = __builtin_amdgcn_mfma_scale_f32_16x16x128_f8f6f4(av, hb1[s2], acc, 4, 4, 0, 127, 0, 127);
          acc = __builtin_amdgcn_mfma_scale_f32_16x16x128_f8f6f4(av, hb2[s2], acc, 4, 4, 0, 127, 0, 125);
        }
        if (r16 == 0) *(f32x4*)(s_part + mt * 16 + 4 * q) = acc;
      }
      wave_fence();
      float v0 = s_part[lane] * (1.f / PEER_HS) + ax.p0, v1 = s_part[64 + lane] * (1.f / PEER_HS) + ax.p1;
      if (c == 3) {
        v0 = gelu_tanh(v0 * (1.f / PEER_SU)) * ax.g0 * (1.f / PEER_SV);
        v1 = gelu_tanh(v1 * (1.f / PEER_SU)) * ax.g1 * (1.f / PEER_SV);
      }
      act[(size_t)tok * 128 + lane] = v0;
      act[(size_t)tok * 128 + 64 + lane] = v1;
    };
    if (K == 0) continue;
    u32x4 rA[16];
    UAux xA, xN;
    int i0, i1;
    load_idx(gw, i0, i1);
    load_aux(xN, gw);
#pragma unroll 1
    for (int k = 0; k < K; ++k) {
      const int tok = gw + k * nw;
      xA = xN;
      wave_fence();
      s_idx[lane] = i0; s_idx[64 + lane] = i1;
      wave_fence();
#pragma unroll
      for (int rb = 0; rb < 16; ++rb) { const int e = s_idx[rb * 8 + rg]; rA[rb] = *(const u32x4*)(uts + (size_t)e * 128); }
      if (k + 1 < K) { load_idx(tok + nw, i0, i1); load_aux(xN, tok + nw); }
      compute(rA, xA, tok);
    }
  }
}

constexpr float PEER_XS = 2.f * PEER_SV;
typedef __attribute__((ext_vector_type(2))) int i32x2;
typedef __attribute__((address_space(3))) i32x2* lds_i32x2_ptr;
struct VAux { float a0, a1; f32x4 xv, gt; };
DI unsigned enc4x8(const float (&x)[8]) {
  unsigned w = 0;
  w = __builtin_amdgcn_cvt_scalef32_pk_fp4_f32(w, x[0], x[1], 1.0f, 0);
  w = __builtin_amdgcn_cvt_scalef32_pk_fp4_f32(w, x[2], x[3], 1.0f, 1);
  w = __builtin_amdgcn_cvt_scalef32_pk_fp4_f32(w, x[4], x[5], 1.0f, 2);
  w = __builtin_amdgcn_cvt_scalef32_pk_fp4_f32(w, x[6], x[7], 1.0f, 3);
  return w;
}
DI void resid4x8(float (&x)[8], unsigned w) {
#pragma unroll
  for (int e = 0; e < 4; ++e) { const fl2_t d = dec4(w, e); x[2 * e] = (x[2 * e] - d[0]) * 4.f; x[2 * e + 1] = (x[2 * e + 1] - d[1]) * 4.f; }
}
DI void gatherV_phase(const Params& P, int layer, char* smem) {
  const int lane = tidx() & 63, wv = tidx() >> 6, rg = lane >> 3, cl = lane & 7, r16 = lane & 15, q = lane >> 4;
  const float* mod = (const float*)(P.ws + WS_MOD) + (size_t)layer * 9 * 6144 + 5 * 1024;
  float* x = (float*)(P.ws + WS_X);
  const unsigned char* vt = (const unsigned char*)(P.ws + WS_PV) + (size_t)layer * 4 * 16384 * 128;
  const int* idx = (const int*)(P.ws + WS_IDX);
  const float* act = (const float*)(P.ws + WS_ACT);
  char* T = smem + wv * 18432;
  int* s_idx = (int*)(smem + wv * 18432 + 17408);
  float* s_act = (float*)(smem + wv * 18432 + 17920);
  const int gw = blockIdx.x * 4 + wv, nw = gridDim.x * 4;
  const int K = gw < NTOK ? (NTOK - 1 - gw) / nw + 1 : 0;
  for (int c = 0; c < 4; ++c) {
    const unsigned char* vts = vt + (size_t)c * 16384 * 128 + cl * 16;
    auto load_tok = [&](int tok, int& i0, int& i1, VAux& ax) {
      i0 = idx[(size_t)tok * 128 + lane]; i1 = idx[(size_t)tok * 128 + 64 + lane];
      ax.a0 = act[(size_t)tok * 128 + lane]; ax.a1 = act[(size_t)tok * 128 + 64 + lane];
      ax.xv = *(const f32x4*)(x + (size_t)tok * D + c * 256 + 4 * lane);
      ax.gt = *(const f32x4*)(mod + (size_t)cond_of(tok) * 6144 + c * 256 + 4 * lane);
    };
    if (K == 0) continue;
    u32x4 rows[16];
    VAux xA, xN;
    int i0, i1;
    load_tok(gw, i0, i1, xN);
#pragma unroll 1
    for (int k = 0; k < K; ++k) {
      const int tok = gw + k * nw;
      xA = xN;
      wave_fence();
      s_idx[lane] = i0; s_idx[64 + lane] = i1;
      s_act[lane] = xA.a0; s_act[64 + lane] = xA.a1;
      wave_fence();
#pragma unroll
      for (int rb = 0; rb < 16; ++rb) { const int e = s_idx[rb * 8 + rg]; rows[rb] = *(const u32x4*)(vts + (size_t)e * 128); }
      if (k + 1 < K) load_tok(tok + nw, i0, i1, xN);
      i32x8 a1v, a2v, a3v, a4v;
      {
        float xv8[8];
        const int d = r16 & 3, term = r16 >> 2;
        const f32x4 s0 = *(const f32x4*)(s_act + 32 * q + 8 * d), s1 = *(const f32x4*)(s_act + 32 * q + 8 * d + 4);
#pragma unroll
        for (int e = 0; e < 4; ++e) { xv8[e] = s0[e] * PEER_XS; xv8[4 + e] = s1[e] * PEER_XS; }
        unsigned w = enc4x8(xv8);
        if (term >= 1) { resid4x8(xv8, w); w = enc4x8(xv8); }
        if (term >= 2) { resid4x8(xv8, w); w = enc4x8(xv8); }
        if (term >= 3) { resid4x8(xv8, w); w = enc4x8(xv8); }
        unsigned* s_h = (unsigned*)s_idx;
        wave_fence();
        s_h[q * 16 + term * 4 + d] = w;
        wave_fence();
        const unsigned* hp = s_h + q * 16;
        a1v = i32x8{(int)hp[0], (int)hp[1], (int)hp[2], (int)hp[3], 0, 0, 0, 0};
        a2v = i32x8{(int)hp[4], (int)hp[5], (int)hp[6], (int)hp[7], 0, 0, 0, 0};
        a3v = i32x8{(int)hp[8], (int)hp[9], (int)hp[10], (int)hp[11], 0, 0, 0, 0};
        a4v = i32x8{(int)hp[12], (int)hp[13], (int)hp[14], (int)hp[15], 0, 0, 0, 0};
      }
      wave_fence();
#pragma unroll
      for (int rb = 0; rb < 16; ++rb) {
        char* tp = T + (rb * 8 + rg) * 136 + cl * 16;
        *(u32x2*)tp = u32x2{rows[rb][0], rows[rb][1]};
        *(u32x2*)(tp + 8) = u32x2{rows[rb][2], rows[rb][3]};
      }
      wave_fence();
      float outv[16];
#pragma unroll
      for (int nt = 0; nt < 16; ++nt) {
        const i32x2 b01 = __builtin_amdgcn_ds_read_tr4_b64_v2i32((lds_i32x2_ptr)(T + (32 * q + r16) * 136 + nt * 8));
        const i32x2 b23 = __builtin_amdgcn_ds_read_tr4_b64_v2i32((lds_i32x2_ptr)(T + (32 * q + 16 + r16) * 136 + nt * 8));
        const i32x8 bv = {b01[0], b01[1], b23[0], b23[1], 0, 0, 0, 0};
        f32x4 acc = {0.f, 0.f, 0.f, 0.f};
        acc = __builtin_amdgcn_mfma_scale_f32_16x16x128_f8f6f4(a1v, bv, acc, 4, 4, 0, 127, 0, 127);
        acc = __builtin_amdgcn_mfma_scale_f32_16x16x128_f8f6f4(a2v, bv, acc, 4, 4, 0, 125, 0, 127);
        acc = __builtin_amdgcn_mfma_scale_f32_16x16x128_f8f6f4(a3v, bv, acc, 4, 4, 0, 123, 0, 127);
        acc = __builtin_amdgcn_mfma_scale_f32_16x16x128_f8f6f4(a4v, bv, acc, 4, 4, 0, 121, 0, 127);
        outv[nt] = acc[0];
      }
      wave_fence();
      float* s_out = (float*)T;
      if (q == 0) {
#pragma unroll
        for (int nt = 0; nt < 16; ++nt) s_out[nt * 16 + r16] = outv[nt];
      }
      wave_fence();
      const f32x4 sum = *(const f32x4*)(s_out + 4 * lane);
      f32x4 res;
#pragma unroll
      for (int e = 0; e < 4; ++e) res[e] = DN_ALPHA * xA.xv[e] + (1.f + xA.gt[e]) * sum[e] * (1.f / PEER_XS);
      *(f32x4*)(x + (size_t)tok * D + c * 256 + 4 * lane) = res;
    }
  }
}

constexpr int ST_LD = 68;
constexpr int ST_WAVE_BYTES = 64 * ST_LD * 4;
template <class F>
DI void wave_tile_epilogue(f32x16 (&acc)[2][2], char* smem, const F& f) {
  const int lane = tidx() & 63, wv = tidx() >> 6, r31 = lane & 31, hh = lane >> 5;
  float* st = (float*)(smem + wv * ST_WAVE_BYTES);
#pragma unroll
  for (int mi = 0; mi < 2; ++mi)
#pragma unroll
    for (int ni = 0; ni < 2; ++ni)
#pragma unroll
      for (int i = 0; i < 16; ++i) st[(mi * 32 + crow(i, hh)) * ST_LD + ni * 32 + r31] = acc[mi][ni][i];
  wave_fence();
#pragma unroll 2
  for (int it = 0; it < 8; ++it) {
    const int row = it * 8 + (lane >> 3), c0 = (lane & 7) * 8;
    f(row, c0, (const float*)(st + row * ST_LD));
  }
}
DI void ld8(const float* p, float (&v)[8]) {
  const f32x4 a = *(const f32x4*)p, b = *(const f32x4*)(p + 4);
  v[0] = a[0]; v[1] = a[1]; v[2] = a[2]; v[3] = a[3]; v[4] = b[0]; v[5] = b[1]; v[6] = b[2]; v[7] = b[3];
}
DI void st8(float* p, const float (&v)[8]) {
  *(f32x4*)p = f32x4{v[0], v[1], v[2], v[3]};
  *(f32x4*)(p + 4) = f32x4{v[4], v[5], v[6], v[7]};
}
DI u32x4 pack8(const float (&v)[8]) { return u32x4{pack_bf16(v[0], v[1]), pack_bf16(v[2], v[3]), pack_bf16(v[4], v[5]), pack_bf16(v[6], v[7])}; }

#define XB_TMO      128
#define XB_XCNT(j)  (256  + 64 * (j))
#define XB_XSUB(j)  (1280 + 64 * (j))
#define XB_XGEN(j)  (2304 + 64 * (j))
#define XB_TOP      3328
#define XB_TOPGEN   3392
#define XCD_BAR_WORDS 3456
#define XB_SPIN_CAP (1u << 18)
#define LAS __attribute__((address_space(3)))
DI unsigned xb_ld(unsigned* p) { return __hip_atomic_load(p, __ATOMIC_RELAXED, __HIP_MEMORY_SCOPE_AGENT); }
DI unsigned xb_add(unsigned* p, unsigned v) { return __hip_atomic_fetch_add(p, v, __ATOMIC_RELAXED, __HIP_MEMORY_SCOPE_AGENT); }
DI unsigned xb_xcc_id() { return (unsigned)__builtin_amdgcn_s_getreg((3 << 11) | 20) & 0xFu; }
#define XB_SPIN(cond, bar) do { unsigned _sp = 0; while (cond) { __builtin_amdgcn_s_sleep(1); \
    if ((++_sp & 255u) == 0u) { if (xb_ld(&(bar)[XB_TMO])) break; if (_sp > XB_SPIN_CAP) { atomicAdd(&(bar)[XB_TMO], 1u); break; } } } } while (0)
struct XcdBarrier { unsigned* bar; unsigned x; volatile LAS unsigned* st; };
DI XcdBarrier xcd_barrier_post(unsigned* bar, volatile LAS unsigned* st) {
  XcdBarrier b; b.bar = bar; b.x = xb_xcc_id(); b.st = st;
  if (__builtin_amdgcn_workitem_id_x() == 0) (void)xb_add(&bar[XB_XCNT(b.x)], 1u);
  return b;
}
DI void xcd_barrier_complete(unsigned* bar, unsigned x, unsigned& nloc, unsigned& nx) {
  const unsigned G = gridDim.x * gridDim.y * gridDim.z;
  unsigned sum, cnt, mine, sp = 0u;
  for (;;) {
    sum = 0u; cnt = 0u; mine = 0u;
#pragma unroll
    for (unsigned j = 0; j < 16; ++j) { const unsigned c = xb_ld(&bar[XB_XCNT(j)]); sum += c; cnt += (c > 0u) ? 1u : 0u; mine = (j == x) ? c : mine; }
    if (sum == G) break;
    __builtin_amdgcn_s_sleep(1);
    if ((++sp & 255u) == 0u) { if (xb_ld(&bar[XB_TMO])) break; if (sp > XB_SPIN_CAP) { atomicAdd(&bar[XB_TMO], 1u); break; } }
  }
  nloc = mine > 0u ? mine : 1u; nx = cnt > 0u ? cnt : 1u;
}
DI void xcd_barrier(const XcdBarrier& b) {
  asm volatile("s_waitcnt vmcnt(0)" ::: "memory");
  __syncthreads();
  if (__builtin_amdgcn_workitem_id_x() == 0) {
    unsigned* bar = b.bar;
    __builtin_amdgcn_s_waitcnt(0);
    unsigned nloc = b.st[0], nx = b.st[1];
    if (nloc == 0u) { xcd_barrier_complete(bar, b.x, nloc, nx); b.st[0] = nloc; b.st[1] = nx; }
    const unsigned old = xb_add(&bar[XB_XSUB(b.x)], 1u);
    const unsigned gen = old / nloc;
    if (old + 1u == (gen + 1u) * nloc) {
      __builtin_amdgcn_fence(__ATOMIC_RELEASE, "agent");
      asm volatile("s_waitcnt vmcnt(0)" ::: "memory");
      const unsigned og = xb_add(&bar[XB_TOP], 1u);
      const unsigned tg = og / nx;
      if (og + 1u == (tg + 1u) * nx) xb_add(&bar[XB_TOPGEN], 1u);
      else XB_SPIN(xb_ld(&bar[XB_TOPGEN]) == tg, bar);
      __builtin_amdgcn_fence(__ATOMIC_ACQUIRE, "agent");
      xb_add(&bar[XB_XGEN(b.x)], 1u);
      asm volatile("s_waitcnt vmcnt(0)" ::: "memory");
    } else {
      XB_SPIN(xb_ld(&bar[XB_XGEN(b.x)]) == gen, bar);
      __builtin_amdgcn_fence(__ATOMIC_ACQUIRE, "agent");
      asm volatile("s_waitcnt vmcnt(0)" ::: "memory");
    }
  }
  __syncthreads();
}

typedef const Params __attribute__((address_space(4)))* KParamPtr;
DI Params load_params() {
#if defined(__HIP_DEVICE_COMPILE__)
  KParamPtr kp = (KParamPtr)__builtin_amdgcn_kernarg_segment_ptr();
  asm volatile("" : "+s"(kp));
  return *kp;
#else
  return Params{};
#endif
}
__global__ void __launch_bounds__(256, 2) fwd_kernel(Params PK) {
  const int p0 = PK.p0, p1 = PK.p1;
  __shared__ __attribute__((aligned(16))) char smem[SMEM_BYTES];
  __shared__ uint4 xb_words;
  cg::grid_group grid = cg::this_grid();
  if (__builtin_amdgcn_workitem_id_x() == 0) xb_words = make_uint4(0u, 0u, 0u, 0u);
  __syncthreads();
  XcdBarrier xb;
  xb.bar = (unsigned*)(PK.ws + WS_BAR); xb.x = 0; xb.st = (volatile LAS unsigned*)&xb_words;
  if (p1 - p0 > 1) xb = xcd_barrier_post((unsigned*)(PK.ws + WS_BAR), (volatile LAS unsigned*)&xb_words);
  int ph = 0;
#ifndef SITEMASK
#define SITEMASK 0xFFFF
#endif
#define PH_BEGIN(id) if (((SITEMASK >> (id)) & 1) && ph >= p0 && ph < p1) { const Params P = load_params();
#define PH_END if (ph + 1 < p1) { if (ph == p0) { asm volatile("s_waitcnt vmcnt(0)" ::: "memory"); grid.sync(); } else xcd_barrier(xb); } } ++ph;
  PH_BEGIN(0) conv_phase(P, smem); PH_END
  PH_BEGIN(1) prep_phase(P); PH_END
  for (int layer = 0; layer < DEPTH; ++layer) {
    const int j = layer >> 1;
    if ((layer & 1) == 0) {
      PH_BEGIN(2) {
        bf16* ub = (bf16*)(P.ws + WS_U);
        auto epi = [&](f32x16(&acc)[2][2], int row0, int col0) {
          wave_tile_epilogue(acc, smem, [&](int row, int c0, const float* rp) {
            float v[8];
            ld8(rp + c0, v);
            *(u32x4*)(ub + (size_t)(row0 + row) * 1024 + col0 + c0) = pack8(v);
          });
        };
        gemm_phase(1024, PlainALF{(const bf16*)(P.ws + WS_H)}, (const bf16*)(P.ws + WS_WIN) + (size_t)j * 1048576, epi, smem);
      } PH_END
      PH_BEGIN(3) scan_phase(P, j, smem); PH_END
      PH_BEGIN(11) comb_phase(P, j); PH_END
      PH_BEGIN(4) {
        bf16* zb = (bf16*)(P.ws + WS_Z);
        auto epi = [&](f32x16(&acc)[2][2], int row0, int col0) {
          wave_tile_epilogue(acc, smem, [&](int row, int c0, const float* rp) {
            if (c0 < 32) {
              float v[8], g[8];
              ld8(rp + c0, v);
              ld8(rp + 32 + c0, g);
#pragma unroll
              for (int e = 0; e < 8; ++e) v[e] *= sigmoidf_(g[e]);
              *(u32x4*)(zb + (size_t)(row0 + row) * 1024 + (col0 >> 1) + c0) = pack8(v);
            }
          });
        };
        gemm_phase(2048, PlainALF{(const bf16*)(P.ws + WS_YF)}, (const bf16*)(P.ws + WS_WGLU) + (size_t)j * 2097152, epi, smem);
      } PH_END
    } else {
      PH_BEGIN(5) {
        bf16* qb = (bf16*)(P.ws + WS_U);
        bf16* kb = (bf16*)(P.ws + WS_YF);
        bf16* vb = (bf16*)(P.ws + WS_YB);
        const float* rt = (const float*)(P.ws + WS_ROPE);
        auto epi = [&](f32x16(&acc)[2][2], int row0, int col0) {
          const bool lat = row0 >= NCTX;
          wave_tile_epilogue(acc, smem, [&](int row, int c0, const float* rp) {
            const int tok = row0 + row;
            float v[8];
            ld8(rp + c0, v);
            if (lat && col0 < 1280) {
              const int pos = (tok - NCTX) & 4095;
              const int pp = (c0 & 32) ? (pos & 63) : (pos >> 6);
              const bool second = (c0 & 16) != 0;
              float o[8], cs[8], sn[8];
              ld8(rp + (second ? c0 - 16 : c0 + 16), o);
              ld8(rt + pp * 16 + (c0 & 15), cs);
              ld8(rt + 1024 + pp * 16 + (c0 & 15), sn);
#pragma unroll
              for (int e = 0; e < 8; ++e) v[e] = second ? (o[e] * sn[e] + v[e] * cs[e]) : (v[e] * cs[e] - o[e] * sn[e]);
            }
            if (col0 < 1024) {
              *(u32x4*)(qb + (size_t)tok * 1024 + col0 + c0) = pack8(v);
            } else if (col0 < 1280) {
              *(u32x4*)(kb + (size_t)tok * 256 + col0 - 1024 + c0) = pack8(v);
              if (!lat) st8(P.out + OUT_CK + (((size_t)(tok >> 8) * 2 + j) * 256 + (tok & 255)) * 256 + col0 - 1024 + c0, v);
            } else {
              *(u32x4*)(vb + (size_t)tok * 256 + col0 - 1280 + c0) = pack8(v);
              if (!lat) st8(P.out + OUT_CV + (((size_t)(tok >> 8) * 2 + j) * 256 + (tok & 255)) * 256 + col0 - 1280 + c0, v);
            }
          });
        };
        gemm_phase(1536, PlainALF{(const bf16*)(P.ws + WS_H)}, (const bf16*)(P.ws + WS_WQKV) + (size_t)j * 1572864, epi, smem);
      } PH_END
      PH_BEGIN(6) attn_phase(P, j, smem); PH_END
    }
    PH_BEGIN(7) {
      const float* mod = (const float*)(P.ws + WS_MOD) + (size_t)layer * 9 * 6144;
      float* xbuf = (float*)(P.ws + WS_X);
      auto epi = [&](f32x16(&acc)[2][2], int row0, int col0) {
        const float* m = mod + (size_t)cond_of(row0) * 6144 + 2 * 1024 + col0;
        wave_tile_epilogue(acc, smem, [&](int row, int c0, const float* rp) {
          float v[8], xv[8], gt[8];
          ld8(rp + c0, v);
          float* xp = xbuf + (size_t)(row0 + row) * 1024 + col0 + c0;
          ld8(xp, xv);
          ld8(m + c0, gt);
#pragma unroll
          for (int e = 0; e < 8; ++e) xv[e] = DN_ALPHA * xv[e] + (1.f + gt[e]) * v[e];
          st8(xp, xv);
        });
      };
      const bf16* wt = (layer & 1) == 0 ? (const bf16*)(P.ws + WS_WOUT) + (size_t)j * 1048576 : (const bf16*)(P.ws + WS_AWOUT) + (size_t)j * 1048576;
      gemm_phase(1024, PlainALF{(const bf16*)(P.ws + WS_Z)}, wt, epi, smem);
    } PH_END
    PH_BEGIN(8) ln_phase(P, layer, 0); PH_END
    PH_BEGIN(9) route_phase(P, layer, smem); PH_END
    PH_BEGIN(10)
      gatherU_phase(P, layer, smem);
      asm volatile("s_waitcnt vmcnt(0)" ::: "memory"); __builtin_amdgcn_fence(__ATOMIC_ACQUIRE, "agent"); asm volatile("s_waitcnt vmcnt(0)" ::: "memory");
      __syncthreads();
      gatherV_phase(P, layer, smem);
      asm volatile("s_waitcnt vmcnt(0)" ::: "memory"); __builtin_amdgcn_fence(__ATOMIC_ACQUIRE, "agent"); asm volatile("s_waitcnt vmcnt(0)" ::: "memory");
      ln_phase(P, layer, 1);
    PH_END
  }
}

constexpr int N_PHASES = 2 + 2 * 8 + 2 * 6;

extern "C" void kernel_launch(void* const* d_in, const int* in_sizes, int n_in, void* d_out, int out_size, void* d_ws, size_t ws_size, hipStream_t stream) {
  static int grid_blocks = 0;
  if (!grid_blocks) {
    int dev = 0, cus = 0, per_cu = 0;
    (void)hipGetDevice(&dev);
    (void)hipDeviceGetAttribute(&cus, hipDeviceAttributeMultiprocessorCount, dev);
    (void)hipOccupancyMaxActiveBlocksPerMultiprocessor(&per_cu, fwd_kernel, 256, 0);
    if (per_cu < 1) per_cu = 1;
    if (per_cu > 2) per_cu = 2;
    grid_blocks = cus * per_cu;
    if (ws_size < WS_END) fprintf(stderr, "kernel_launch: workspace too small: %zu < %zu\n", ws_size, (size_t)WS_END);
  }
  Params p;
  memset(&p, 0, sizeof(p));
  const float** fp = (const float**)&p;
  for (int i = 0; i < 30; ++i) fp[i] = (const float*)d_in[i];
  p.out = (float*)d_out;
  p.ws = (char*)d_ws;
  (void)hipMemsetAsync((char*)d_ws + WS_BAR, 0, XCD_BAR_WORDS * sizeof(unsigned), stream);
#if MULTI_LAUNCH
  for (int ph = 0; ph < N_PHASES; ++ph) {
    p.p0 = ph; p.p1 = ph + 1;
    hipLaunchKernelGGL(fwd_kernel, dim3(grid_blocks), dim3(256), 0, stream, p);
  }
#else
  p.p0 = 0; p.p1 = N_PHASES;
  void* args[] = {&p};
  hipError_t e = hipLaunchCooperativeKernel((void*)fwd_kernel, dim3(grid_blocks), dim3(256), args, 0, stream);
  if (e != hipSuccess) fprintf(stderr, "cooperative launch failed: %s (grid %d)\n", hipGetErrorString(e), grid_blocks);
#endif
}
```

```cpp
#include <hip/hip_runtime.h>
#include <hip/hip_cooperative_groups.h>
#include <stdint.h>
#include <stdio.h>
#include <string.h>
namespace cg = cooperative_groups;

#ifndef MULTI_LAUNCH
#define MULTI_LAUNCH 0
#endif

#define DI __device__ __forceinline__
typedef unsigned short bf16;
typedef __attribute__((ext_vector_type(8))) short bf16x8;
typedef __attribute__((ext_vector_type(16))) float f32x16;
typedef __attribute__((ext_vector_type(4))) float f32x4;
typedef __attribute__((ext_vector_type(4))) unsigned u32x4;
typedef __attribute__((ext_vector_type(2))) unsigned u32x2;
typedef __bf16 bf2_t __attribute__((ext_vector_type(2)));
typedef float fl2_t __attribute__((ext_vector_type(2)));

#define MFMA32(a, b, c) __builtin_amdgcn_mfma_f32_32x32x16_bf16((a), (b), (c), 0, 0, 0)

constexpr int D = 1024;
constexpr int NCTX = 8192;
constexpr int NTOK = 40960;
constexpr int DEPTH = 4;
constexpr float DN_ALPHA = 1.681792830507429f;
constexpr float LN_EPS = 1e-5f;

constexpr size_t OUT_Y = 0;
constexpr size_t OUT_SRE = 41943040;
constexpr size_t OUT_SIM = 42467328;
constexpr size_t OUT_CK = 42991616;
constexpr size_t OUT_CV = 47185920;

constexpr size_t MiB = 1048576;
constexpr size_t WS_WIN = 0;
constexpr size_t WS_WGLU = WS_WIN + 4 * MiB;
constexpr size_t WS_WOUT = WS_WGLU + 8 * MiB;
constexpr size_t WS_WQKV = WS_WOUT + 4 * MiB;
constexpr size_t WS_AWOUT = WS_WQKV + 6 * MiB;
constexpr size_t WS_WQ = WS_AWOUT + 4 * MiB;
constexpr size_t WS_KEYS = WS_WQ + 16 * MiB;
constexpr size_t WS_PU = WS_KEYS + 2 * MiB;
constexpr size_t WS_PV = WS_PU + 128 * MiB;
constexpr size_t WS_CK = WS_PV + 128 * MiB;
constexpr size_t WS_CV = WS_CK + 4 * MiB;
constexpr size_t WS_MOD = WS_CV + 4 * MiB;
constexpr size_t WS_ROPE = WS_MOD + 1 * MiB;
constexpr size_t WS_X = WS_ROPE + 1 * MiB;
constexpr size_t WS_H = WS_X + 160 * MiB;
constexpr size_t WS_U = WS_H + 80 * MiB;
constexpr size_t WS_YF = WS_U + 80 * MiB;
constexpr size_t WS_YB = WS_YF + 80 * MiB;
constexpr size_t WS_Z = WS_YB + 80 * MiB;
constexpr size_t WS_IDX = WS_Z + 80 * MiB;
constexpr size_t WS_G = WS_IDX + 20 * MiB;
constexpr size_t WS_BAR = WS_G + 20 * MiB;
constexpr size_t WS_ACT = WS_BAR + 1 * MiB;
constexpr size_t WS_END = WS_ACT + 20 * MiB;

struct Params {
  const float *x_prompt, *x_sample, *st_re, *st_im, *cache_k, *cache_v, *c, *c_ctx, *w_mod, *b_mod, *ln_g, *ln_b;
  const float *ssm_w_in, *ssm_a_re, *ssm_a_im, *ssm_log_dt, *ssm_b_re, *ssm_b_im, *ssm_c_re, *ssm_c_im, *ssm_d, *ssm_w_glu, *ssm_w_out;
  const float *attn_w_qkv, *attn_sink, *attn_w_out, *peer_w_q, *peer_keys, *peer_u, *peer_v;
  float* out;
  char* ws;
  int p0, p1;
};

DI int tidx() { int t = (int)__builtin_amdgcn_workitem_id_x(); asm volatile("" : "+v"(t)); return t; }
DI unsigned pack_bf16(float lo, float hi) { fl2_t f = {lo, hi}; bf2_t b = __builtin_convertvector(f, bf2_t); return __builtin_bit_cast(unsigned, b); }
DI float bf_lo(unsigned w) { return __uint_as_float(w << 16); }
DI float bf_hi(unsigned w) { return __uint_as_float(w & 0xffff0000u); }
DI f32x4 unpack4(u32x2 w) { return f32x4{__uint_as_float(w[0] << 16), __uint_as_float(w[0] & 0xffff0000u), __uint_as_float(w[1] << 16), __uint_as_float(w[1] & 0xffff0000u)}; }
DI float bf1(bf16 v) { return __uint_as_float(((unsigned)v) << 16); }
DI bf16 f2bf(float x) { return (bf16)(pack_bf16(x, 0.f) & 0xffffu); }
DI float gelu_tanh(float x) { float z = 0.7978845608028654f * (x + 0.044715f * x * x * x); return x / (1.f + __expf(-2.f * z)); }
DI float sigmoidf_(float x) { return 1.f / (1.f + __expf(-x)); }
DI int crow(int i, int h) { return (i & 3) + 8 * (i >> 2) + 4 * h; }
DI int cond_of(int tok) { return tok < NCTX ? 0 : 1 + ((tok - NCTX) >> 12); }
DI void wave_fence() { asm volatile("" ::: "memory"); __builtin_amdgcn_wave_barrier(); asm volatile("" ::: "memory"); }
DI float wave_sum(float v) {
#pragma unroll
  for (int o = 32; o > 0; o >>= 1) v += __shfl_xor(v, o);
  return v;
}
DI int imax(int a, int b) { return a > b ? a : b; }
DI int imin(int a, int b) { return a < b ? a : b; }
DI int f2key(float f) { int b = __float_as_int(f); return b ^ ((b >> 31) & 0x7fffffff); }
DI int key2bits(int k) { return k ^ ((k >> 31) & 0x7fffffff); }
DI int bsel(int mask, int a, int b) { return (a & ~mask) | (b & mask); }

DI void cswap(int& a, int& b) { int mx = imax(a, b), mn = imin(a, b); a = mx; b = mn; }
template <int N, int OFF>
DI void sort16_desc(int (&v)[N]) {
#pragma unroll
  for (int k = 2; k <= 16; k <<= 1) {
#pragma unroll
    for (int jj = k >> 1; jj > 0; jj >>= 1) {
#pragma unroll
      for (int i = 0; i < 16; ++i) {
        const int l = i ^ jj;
        if (l > i) {
          if ((i & k) == 0) cswap(v[OFF + i], v[OFF + l]);
          else cswap(v[OFF + l], v[OFF + i]);
        }
      }
    }
  }
}
template <int N, int OA, int OB>
DI void merge16_desc(int (&v)[N]) {
#pragma unroll
  for (int i = 0; i < 16; ++i) v[OA + i] = imax(v[OA + i], v[OB + 15 - i]);
#pragma unroll
  for (int jj = 8; jj > 0; jj >>= 1) {
#pragma unroll
    for (int i = 0; i < 16; ++i) {
      const int l = i ^ jj;
      if (l > i) cswap(v[OA + i], v[OA + l]);
    }
  }
}
template <int N>
DI void pair_merge16(int (&v)[N]) {
  static_assert(N >= 32, "");
#pragma unroll
  for (int i = 0; i < 16; ++i) v[16 + i] = __shfl_xor(v[i], 32);
  merge16_desc<N, 0, 16>(v);
}

constexpr int BK = 64;
constexpr int LROW = 144;
constexpr int TILE_BYTES = 128 * LROW;
constexpr int SMEM_BYTES = 4 * TILE_BYTES;

struct PlainLoad {
  const bf16* base;
  int ld;
  DI u32x4 operator()(int row, int k) const { return *(const u32x4*)(base + (size_t)row * ld + k); }
};

template <int MB, int NB, class AL, class BL>
DI void mainloop(f32x16 (&acc)[MB][NB], const AL& al, const BL& bl, int K, char* smem, int arow0, int brow0) {
  const int tid = tidx(), lane = tid & 63, r31 = lane & 31, hh = lane >> 5;
#pragma unroll
  for (int a = 0; a < MB; ++a)
#pragma unroll
    for (int b = 0; b < NB; ++b)
#pragma unroll
      for (int i = 0; i < 16; ++i) acc[a][b][i] = 0.f;
  u32x4 ra[4], rb[4];
  const int KT = K / BK;
#pragma unroll
  for (int i = 0; i < 4; ++i) { const int c = tid + 256 * i; ra[i] = al(c >> 3, (c & 7) * 8); rb[i] = bl(c >> 3, (c & 7) * 8); }
#pragma unroll
  for (int i = 0; i < 4; ++i) {
    const int c = tid + 256 * i;
    *(u32x4*)(smem + (c >> 3) * LROW + (c & 7) * 16) = ra[i];
    *(u32x4*)(smem + 2 * TILE_BYTES + (c >> 3) * LROW + (c & 7) * 16) = rb[i];
  }
  __syncthreads();
  for (int kt = 0; kt < KT; ++kt) {
    const int buf = kt & 1;
    if (kt + 1 < KT) {
#pragma unroll
      for (int i = 0; i < 4; ++i) { const int c = tid + 256 * i; ra[i] = al(c >> 3, (kt + 1) * BK + (c & 7) * 8); rb[i] = bl(c >> 3, (kt + 1) * BK + (c & 7) * 8); }
    }
    const char* sa = smem + buf * TILE_BYTES + (arow0 + r31) * LROW + hh * 16;
    const char* sb = smem + (2 + buf) * TILE_BYTES + (brow0 + r31) * LROW + hh * 16;
#pragma unroll
    for (int s = 0; s < 4; ++s) {
      bf16x8 af[MB], bfv[NB];
#pragma unroll
      for (int a = 0; a < MB; ++a) af[a] = *(const bf16x8*)(sa + a * 32 * LROW + s * 32);
#pragma unroll
      for (int b = 0; b < NB; ++b) bfv[b] = *(const bf16x8*)(sb + b * 32 * LROW + s * 32);
#pragma unroll
      for (int a = 0; a < MB; ++a)
#pragma unroll
        for (int b = 0; b < NB; ++b) acc[a][b] = MFMA32(af[a], bfv[b], acc[a][b]);
    }
    if (kt + 1 < KT) {
#pragma unroll
      for (int i = 0; i < 4; ++i) {
        const int c = tid + 256 * i;
        *(u32x4*)(smem + (buf ^ 1) * TILE_BYTES + (c >> 3) * LROW + (c & 7) * 16) = ra[i];
        *(u32x4*)(smem + (2 + (buf ^ 1)) * TILE_BYTES + (c >> 3) * LROW + (c & 7) * 16) = rb[i];
      }
    }
    __syncthreads();
  }
}

DI int glu_perm(int n) { return n < 1024 ? ((n >> 5) * 64 + (n & 31)) : (((n - 1024) >> 5) * 64 + 32 + ((n - 1024) & 31)); }

DI void conv_transpose_tile(const float* src, int N, bf16* dst, int tk, int tn, bool perm, char* smem) {
  bf16* T = (bf16*)smem;
  const int tid = tidx();
  __syncthreads();
#pragma unroll
  for (int ps = 0; ps < 4; ++ps) {
    const int r = ps * 16 + (tid >> 4), c4 = (tid & 15) * 4;
    const f32x4 v = *(const f32x4*)(src + (size_t)(tk * 64 + r) * N + tn * 64 + c4);
#pragma unroll
    for (int e = 0; e < 4; ++e) T[(c4 + e) * 66 + r] = f2bf(v[e]);
  }
  __syncthreads();
  const int c = tid >> 2, seg = tid & 3;
  int n = tn * 64 + c;
  if (perm) n = glu_perm(n);
  unsigned w[8];
#pragma unroll
  for (int e = 0; e < 8; ++e) w[e] = (unsigned)T[c * 66 + seg * 16 + 2 * e] | ((unsigned)T[c * 66 + seg * 16 + 2 * e + 1] << 16);
  bf16* d = dst + (size_t)n * 1024 + tk * 64 + seg * 16;
  *(u32x4*)d = u32x4{w[0], w[1], w[2], w[3]};
  *(u32x4*)(d + 8) = u32x4{w[4], w[5], w[6], w[7]};
}

DI void conv_elem(const float* src, bf16* dst, size_t base) {
  const size_t e = base + (size_t)tidx() * 8;
  const f32x4 a = *(const f32x4*)(src + e), b = *(const f32x4*)(src + e + 4);
  *(u32x4*)(dst + e) = u32x4{pack_bf16(a[0], a[1]), pack_bf16(a[2], a[3]), pack_bf16(b[0], b[1]), pack_bf16(b[2], b[3])};
}

constexpr float PEER_SU = 64.f, PEER_SV = 13.f;
DI unsigned enc_fp4(float x, float sc) {
  const float a = fabsf(x * sc);
  const unsigned code = (unsigned)(a >= 0.25f) + (unsigned)(a >= 0.75f) + (unsigned)(a >= 1.25f) + (unsigned)(a >= 1.75f) +
                        (unsigned)(a >= 2.5f) + (unsigned)(a >= 3.5f) + (unsigned)(a >= 5.f);
  return code | (x < 0.f ? 8u : 0u);
}
DI void conv_elem_fp4(const float* src, unsigned char* dst, size_t base, float sc) {
  const size_t e = base + (size_t)tidx() * 32;
  const size_t le = e >> 10, col = e & 1023;
  unsigned dw[4] = {0u, 0u, 0u, 0u};
#pragma unroll
  for (int q4 = 0; q4 < 8; ++q4) {
    const f32x4 v = *(const f32x4*)(src + e + 4 * q4);
#pragma unroll
    for (int t = 0; t < 4; ++t) { const int k = 4 * q4 + t; dw[k >> 3] |= enc_fp4(v[t], sc) << (4 * (k & 7)); }
  }
  unsigned char* p = dst + (((le >> 14) * 4 + (col >> 8)) * 16384 + (le & 16383)) * 128 + ((col & 255) >> 1);
  *(u32x4*)p = u32x4{dw[0], dw[1], dw[2], dw[3]};
}
DI unsigned pack4_fp8(float a, float b, float c, float d, float sc) {
  a = fminf(fmaxf(a * sc, -448.f), 448.f); b = fminf(fmaxf(b * sc, -448.f), 448.f);
  c = fminf(fmaxf(c * sc, -448.f), 448.f); d = fminf(fmaxf(d * sc, -448.f), 448.f);
  int p = 0;
  p = __builtin_amdgcn_cvt_pk_fp8_f32(a, b, p, false);
  p = __builtin_amdgcn_cvt_pk_fp8_f32(c, d, p, true);
  return (unsigned)p;
}
DI void conv_elem_fp8(const float* src, unsigned char* dst, size_t base, float sc) {
  const size_t e = base + (size_t)tidx() * 16;
  const size_t le = e >> 10, col = e & 1023;
  const size_t de = (((le >> 14) * 8 + (col >> 7)) * 16384 + (le & 16383)) * 128 + (col & 127);
  const f32x4 a = *(const f32x4*)(src + e), b = *(const f32x4*)(src + e + 4), c = *(const f32x4*)(src + e + 8), d = *(const f32x4*)(src + e + 12);
  *(u32x4*)(dst + de) = u32x4{pack4_fp8(a[0], a[1], a[2], a[3], sc), pack4_fp8(b[0], b[1], b[2], b[3], sc), pack4_fp8(c[0], c[1], c[2], c[3], sc), pack4_fp8(d[0], d[1], d[2], d[3], sc)};
}

DI void conv_phase(const Params& P, char* smem) {
  const int tid = tidx();
  constexpr int N_MOD = 384, N_TR = 5376, N_EL = 512 + 16384 + 2048;
  for (int item = blockIdx.x; item < N_MOD + N_TR + N_EL + 1; item += gridDim.x) {
    if (item < N_MOD) {
      const int layer = item / 96, cgp = item % 96;
      float* ssilu = (float*)smem;
      float* red = (float*)(smem + 36864);
      __syncthreads();
      for (int o = tid; o < 9 * 1024; o += 256) {
        const int cc = o >> 10, k = o & 1023;
        const float v = cc == 0 ? P.c_ctx[k] : P.c[(cc - 1) * 1024 + k];
        ssilu[o] = v / (1.f + __expf(-v));
      }
      __syncthreads();
      const int kq = tid >> 6, n = tid & 63;
      float acc[9];
#pragma unroll
      for (int cc = 0; cc < 9; ++cc) acc[cc] = 0.f;
      const float* wp = P.w_mod + ((size_t)layer * 1024 + kq * 256) * 6144 + cgp * 64 + n;
#pragma unroll 16
      for (int k = 0; k < 256; ++k) {
        const float w = wp[(size_t)k * 6144];
#pragma unroll
        for (int cc = 0; cc < 9; ++cc) acc[cc] += ssilu[cc * 1024 + kq * 256 + k] * w;
      }
#pragma unroll
      for (int cc = 0; cc < 9; ++cc) red[(kq * 9 + cc) * 64 + n] = acc[cc];
      __syncthreads();
      for (int o = tid; o < 576; o += 256) {
        const int cc = o >> 6, nn = o & 63;
        const float s = red[(0 * 9 + cc) * 64 + nn] + red[(1 * 9 + cc) * 64 + nn] + red[(2 * 9 + cc) * 64 + nn] + red[(3 * 9 + cc) * 64 + nn];
        ((float*)(P.ws + WS_MOD))[((size_t)layer * 9 + cc) * 6144 + cgp * 64 + nn] = s + P.b_mod[layer * 6144 + cgp * 64 + nn];
      }
    } else if (item < N_MOD + N_TR) {
      int t = item - N_MOD;
      const float* src; bf16* dst; int N; bool perm = false;
      if (t < 512) { const int j = t >> 8; t &= 255; src = P.ssm_w_in + (size_t)j * 1048576; dst = (bf16*)(P.ws + WS_WIN) + (size_t)j * 1048576; N = 1024; }
      else if (t < 1536) { t -= 512; const int j = t >> 9; t &= 511; src = P.ssm_w_glu + (size_t)j * 2097152; dst = (bf16*)(P.ws + WS_WGLU) + (size_t)j * 2097152; N = 2048; perm = true; }
      else if (t < 2048) { t -= 1536; const int j = t >> 8; t &= 255; src = P.ssm_w_out + (size_t)j * 1048576; dst = (bf16*)(P.ws + WS_WOUT) + (size_t)j * 1048576; N = 1024; }
      else if (t < 2816) { t -= 2048; const int j = t / 384; t %= 384; src = P.attn_w_qkv + (size_t)j * 1572864; dst = (bf16*)(P.ws + WS_WQKV) + (size_t)j * 1572864; N = 1536; }
      else if (t < 3328) { t -= 2816; const int j = t >> 8; t &= 255; src = P.attn_w_out + (size_t)j * 1048576; dst = (bf16*)(P.ws + WS_AWOUT) + (size_t)j * 1048576; N = 1024; }
      else { t -= 3328; const int j = t >> 9; t &= 511; src = P.peer_w_q + (size_t)j * 2097152; dst = (bf16*)(P.ws + WS_WQ) + (size_t)j * 2097152; N = 2048; }
      const int ntn = N / 64;
      conv_transpose_tile(src, N, dst, t / ntn, t % ntn, perm, smem);
    } else if (item < N_MOD + N_TR + N_EL) {
      int t = item - N_MOD - N_TR;
      if (t < 512) conv_elem(P.peer_keys, (bf16*)(P.ws + WS_KEYS), (size_t)t * 2048);
      else if (t < 512 + 8192) conv_elem_fp4(P.peer_u, (unsigned char*)(P.ws + WS_PU), (size_t)(t - 512) * 8192, PEER_SU);
      else if (t < 512 + 16384) conv_elem_fp4(P.peer_v, (unsigned char*)(P.ws + WS_PV), (size_t)(t - 512 - 8192) * 8192, PEER_SV);
      else if (t < 512 + 16384 + 1024) conv_elem(P.cache_k, (bf16*)(P.ws + WS_CK), (size_t)(t - 512 - 16384) * 2048);
      else conv_elem(P.cache_v, (bf16*)(P.ws + WS_CV), (size_t)(t - 512 - 16384 - 1024) * 2048);
    } else {
      float* rt = (float*)(P.ws + WS_ROPE);
      for (int o = tid; o < 1024; o += 256) {
        const int pos = o >> 4, f = o & 15;
        const float inv = powf(10000.f, -(float)f / 16.f);
        const float ang = (float)pos * inv;
        rt[o] = cosf(ang);
        rt[1024 + o] = sinf(ang);
      }
    }
  }
}

DI void prep_phase(const Params& P) {
  const float* mod = (const float*)(P.ws + WS_MOD);
  bf16* x = (bf16*)(P.ws + WS_X);
  bf16* h = (bf16*)(P.ws + WS_H);
  const size_t nvec = (size_t)NTOK * D / 8;
  for (size_t v = (size_t)blockIdx.x * 256 + tidx(); v < nvec; v += (size_t)gridDim.x * 256) {
    const int tok = (int)(v >> 7), col = (int)(v & 127) * 8;
    const float* src = tok < NCTX ? P.x_prompt + (size_t)tok * D + col : P.x_sample + (size_t)(tok - NCTX) * D + col;
    const f32x4 a = *(const f32x4*)src, b = *(const f32x4*)(src + 4);
    *(u32x4*)(x + (size_t)tok * D + col) = u32x4{pack_bf16(a[0], a[1]), pack_bf16(a[2], a[3]), pack_bf16(b[0], b[1]), pack_bf16(b[2], b[3])};
    const float* m = mod + (size_t)cond_of(tok) * 6144;
    const f32x4 sh0 = *(const f32x4*)(m + col), sh1 = *(const f32x4*)(m + col + 4);
    const f32x4 sc0 = *(const f32x4*)(m + 1024 + col), sc1 = *(const f32x4*)(m + 1024 + col + 4);
    float r[8];
#pragma unroll
    for (int e = 0; e < 4; ++e) { r[e] = a[e] * (1.f + sc0[e]) + sh0[e]; r[4 + e] = b[e] * (1.f + sc1[e]) + sh1[e]; }
    *(u32x4*)(h + (size_t)tok * D + col) = u32x4{pack_bf16(r[0], r[1]), pack_bf16(r[2], r[3]), pack_bf16(r[4], r[5]), pack_bf16(r[6], r[7])};
  }
}

template <class ALF, class EPI>
DI void gemm_phase(int N, const ALF& alf, const bf16* Bt, const EPI& epi, char* smem) {
  const int wv = tidx() >> 6;
  const int wm = wv >> 1, wn = wv & 1;
  const int ntn = N / 128;
  const int xcd = blockIdx.x & 7, lb = blockIdx.x >> 3, nlb = (gridDim.x + 7 - xcd) >> 3;
  const int ntx = ((NTOK / 128) - xcd + 7) >> 3;
  for (int t = lb; t < ntx * ntn; t += nlb) {
    const int tm = xcd + 8 * (t / ntn), tn = t % ntn;
    f32x16 acc[2][2];
    auto al = alf(tm * 128);
    PlainLoad bl{Bt + (size_t)tn * 128 * 1024, 1024};
    mainloop<2, 2>(acc, al, bl, 1024, smem, wm * 64, wn * 64);
    epi(acc, tm * 128 + wm * 64, tn * 128 + wn * 64);
    __syncthreads();
  }
}

struct PlainALF {
  const bf16* A;
  DI PlainLoad operator()(int m0) const { return PlainLoad{A + (size_t)m0 * 1024, 1024}; }
};

struct CombLoad {
  const bf16 *yf, *yb, *u;
  const float* d;
  DI u32x4 operator()(int row, int k) const {
    const size_t o = (size_t)row * 1024 + k;
    const u32x4 a = *(const u32x4*)(yf + o), b = *(const u32x4*)(yb + o), c = *(const u32x4*)(u + o);
    const f32x4 d0 = *(const f32x4*)(d + k), d1 = *(const f32x4*)(d + k + 4);
    unsigned r[4];
#pragma unroll
    for (int e = 0; e < 4; ++e) {
      const float dl = e < 2 ? d0[2 * e] : d1[2 * e - 4], dh = e < 2 ? d0[2 * e + 1] : d1[2 * e - 3];
      const float lo = bf_lo(a[e]) + bf_lo(b[e]) + dl * bf_lo(c[e]);
      const float hi = bf_hi(a[e]) + bf_hi(b[e]) + dh * bf_hi(c[e]);
      r[e] = pack_bf16(gelu_tanh(lo), gelu_tanh(hi));
    }
    return u32x4{r[0], r[1], r[2], r[3]};
  }
};
struct CombALF {
  const bf16 *yf, *yb, *u;
  const float* d;
  DI CombLoad operator()(int m0) const { const size_t o = (size_t)m0 * 1024; return CombLoad{yf + o, yb + o, u + o, d}; }
};

DI void comb_phase(const Params& P, int j) {
  bf16* yf = (bf16*)(P.ws + WS_YF);
  const bf16* yb = (const bf16*)(P.ws + WS_YB);
  const bf16* u = (const bf16*)(P.ws + WS_U);
  const float* d = P.ssm_d + (size_t)j * 1024;
  const size_t nvec = (size_t)NTOK * D / 8;
  for (size_t v = (size_t)blockIdx.x * 256 + tidx(); v < nvec; v += (size_t)gridDim.x * 256) {
    const int k = (int)(v & 127) * 8;
    const u32x4 a = *(const u32x4*)(yf + v * 8), b = *(const u32x4*)(yb + v * 8), c = *(const u32x4*)(u + v * 8);
    const f32x4 d0 = *(const f32x4*)(d + k), d1 = *(const f32x4*)(d + k + 4);
    unsigned r[4];
#pragma unroll
    for (int e = 0; e < 4; ++e) {
      const float dl = e < 2 ? d0[2 * e] : d1[2 * e - 4], dh = e < 2 ? d0[2 * e + 1] : d1[2 * e - 3];
      const float lo = bf_lo(a[e]) + bf_lo(b[e]) + dl * bf_lo(c[e]);
      const float hi = bf_hi(a[e]) + bf_hi(b[e]) + dh * bf_hi(c[e]);
      r[e] = pack_bf16(gelu_tanh(lo), gelu_tanh(hi));
    }
    *(u32x4*)(yf + v * 8) = u32x4{r[0], r[1], r[2], r[3]};
  }
}

template <int DIR>
DI void scan_chunks(const bf16* ubuf, bf16* ybuf, float* bu, char* Hs, const bf16x8 (&bfrag)[4], const bf16x8 (&cfrag)[8],
                    float abr, float abi, float& hre, float& him, int tok0, int nchunks, int g) {
  const int lane = tidx() & 63, r31 = lane & 31, hh = lane >> 5;
  f32x16 zero;
#pragma unroll
  for (int i = 0; i < 16; ++i) zero[i] = 0.f;
  bf16x8 ua_next = *(const bf16x8*)(ubuf + (size_t)(tok0 + (DIR ? nchunks - 1 : 0) * 32 + r31) * 1024 + g * 16 + 8 * hh);
  for (int ci = 0; ci < nchunks; ++ci) {
    const int cidx = DIR ? nchunks - 1 - ci : ci;
    const int t0 = tok0 + cidx * 32;
    const bf16x8 ua = ua_next;
    if (ci + 1 < nchunks) {
      const int cn = DIR ? nchunks - 2 - ci : ci + 1;
      ua_next = *(const bf16x8*)(ubuf + (size_t)(tok0 + cn * 32 + r31) * 1024 + g * 16 + 8 * hh);
    }
    f32x16 acc[4];
#pragma unroll
    for (int blk = 0; blk < 4; ++blk) acc[blk] = MFMA32(ua, bfrag[blk], zero);
#pragma unroll
    for (int hf2 = 0; hf2 < 2; ++hf2) {
      constexpr int dsel = DIR;
      const int hf = dsel ? 1 - hf2 : hf2;
#pragma unroll
      for (int blk = 0; blk < 4; ++blk)
#pragma unroll
        for (int i = 0; i < 8; ++i) bu[crow(i, hh) * 128 + 32 * blk + r31] = acc[blk][8 * hf + i];
      wave_fence();
      fl2_t bvs[16];
#pragma unroll
      for (int s = 0; s < 16; ++s) bvs[s] = *(const fl2_t*)(bu + (DIR ? 15 - s : s) * 128 + 2 * lane);
      asm volatile("" ::: "memory");
#pragma unroll
      for (int s = 0; s < 16; ++s) {
        const int tl = DIR ? 15 - s : s;
        const fl2_t bv = bvs[s];
        float nre = __builtin_fmaf(abr, hre, __builtin_fmaf(-abi, him, bv[0]));
        asm volatile("" : "+v"(nre));
        float nim = __builtin_fmaf(abr, him, __builtin_fmaf(abi, hre, bv[1]));
        asm volatile("" : "+v"(nim));
        hre = nre; him = nim;
        *(unsigned*)(Hs + (hf * 16 + tl) * 272 + lane * 4) = pack_bf16(hre, him);
      }
      wave_fence();
    }
    f32x16 y = zero, y2 = zero;
#pragma unroll
    for (int s = 0; s < 8; s += 2) {
      const bf16x8 a = *(const bf16x8*)(Hs + r31 * 272 + s * 32 + hh * 16);
      const bf16x8 a2 = *(const bf16x8*)(Hs + r31 * 272 + (s + 1) * 32 + hh * 16);
      y = MFMA32(a, cfrag[s], y);
      y2 = MFMA32(a2, cfrag[s + 1], y2);
    }
    wave_fence();
    bf16* ys = (bf16*)bu;
    if (r31 < 16) {
#pragma unroll
      for (int i = 0; i < 16; ++i) ys[crow(i, hh) * 16 + r31] = f2bf(y[i] + y2[i]);
    }
    wave_fence();
    {
      const u32x4 w = *(const u32x4*)(ys + (lane >> 1) * 16 + (lane & 1) * 8);
      *(u32x4*)(ybuf + (size_t)(t0 + (lane >> 1)) * 1024 + g * 16 + (lane & 1) * 8) = w;
    }
    wave_fence();
  }
}

DI void scan_phase(const Params& P, int j, char* smem) {
  const int lane = tidx() & 63, wv = tidx() >> 6, r31 = lane & 31, hh = lane >> 5;

  float* bu = (float*)(smem + wv * 16896);
  char* Hs = smem + wv * 16896 + 8192;
  const bf16* ubuf = (const bf16*)(P.ws + WS_U);
  f32x16 zero;
#pragma unroll
  for (int i = 0; i < 16; ++i) zero[i] = 0.f;
  const bool split = gridDim.x >= 320;
  const int it0 = split ? (blockIdx.x < 256 ? (int)blockIdx.x : 256 + ((int)blockIdx.x - 256)) : (int)blockIdx.x;
  const int itstep = split ? (blockIdx.x < 256 ? 1 << 20 : (int)gridDim.x - 256) : (int)gridDim.x;
  for (int item = it0; item < 1280; item += itstep) {
    const bool lat = item < 256;
    const int cc = lat ? item : item - 256;
    const int dir = cc & 1, g = ((cc >> 1) & 15) * 4 + wv, b = cc >> 5;
    const int L = lat ? 4096 : 256;
    const int tok0 = lat ? NCTX + b * 4096 : b * 256;
    const int pidx = (j * 2 + dir) * 64 + g;
    const float dt = __expf(P.ssm_log_dt[pidx]);
    float abr, abi;
    {
      const float are = P.ssm_a_re[pidx * 64 + lane], aim = P.ssm_a_im[pidx * 64 + lane];
      const float mag = __expf(are * dt);
      float sn, cs;
      sincosf(aim * dt, &sn, &cs);
      abr = mag * cs; abi = mag * sn;
    }
    bf16x8 bfrag[4];
#pragma unroll
    for (int blk = 0; blk < 4; ++blk) {
      const int n = 32 * blk + r31, p = n >> 1, part = n & 1;
      const float are = P.ssm_a_re[pidx * 64 + p], aim = P.ssm_a_im[pidx * 64 + p];
      const float mag = __expf(are * dt);
      float sn, cs;
      sincosf(aim * dt, &sn, &cs);
      const float xr = mag * cs - 1.f, xi = mag * sn;
      const float den = 1.f / (are * are + aim * aim);
      const float cr = (xr * are + xi * aim) * den, ci = (xi * are - xr * aim) * den;
      const float* br = P.ssm_b_re + ((size_t)pidx * 64 + p) * 16 + 8 * hh;
      const float* bi = P.ssm_b_im + ((size_t)pidx * 64 + p) * 16 + 8 * hh;
      unsigned w[4];
#pragma unroll
      for (int e = 0; e < 4; ++e) {
        const float r0 = br[2 * e], i0 = bi[2 * e], r1 = br[2 * e + 1], i1 = bi[2 * e + 1];
        const float v0 = part ? (cr * i0 + ci * r0) : (cr * r0 - ci * i0);
        const float v1 = part ? (cr * i1 + ci * r1) : (cr * r1 - ci * i1);
        w[e] = pack_bf16(v0, v1);
      }
      bfrag[blk] = __builtin_bit_cast(bf16x8, u32x4{w[0], w[1], w[2], w[3]});
    }
    bf16x8 cfrag[8];
#pragma unroll
    for (int s = 0; s < 8; ++s) {
      unsigned w[4];
#pragma unroll
      for (int e = 0; e < 4; ++e) {
        const int p = 8 * s + 4 * hh + e;
        float v0 = 0.f, v1 = 0.f;
        if (r31 < 16) {
          v0 = P.ssm_c_re[((size_t)pidx * 16 + r31) * 64 + p];
          v1 = -P.ssm_c_im[((size_t)pidx * 16 + r31) * 64 + p];
        }
        w[e] = pack_bf16(v0, v1);
      }
      cfrag[s] = __builtin_bit_cast(bf16x8, u32x4{w[0], w[1], w[2], w[3]});
    }
    float hre = 0.f, him = 0.f;
    if (lat) {
      const size_t si = ((((size_t)b * 2 + j) * 2 + dir) * 64 + g) * 64 + lane;
      hre = P.st_re[si]; him = P.st_im[si];
    }
    bf16* ybuf = (bf16*)(P.ws + (dir ? WS_YB : WS_YF));
    const int nchunks = L / 32;
    if (dir) scan_chunks<1>(ubuf, ybuf, bu, Hs, bfrag, cfrag, abr, abi, hre, him, tok0, nchunks, g);
    else scan_chunks<0>(ubuf, ybuf, bu, Hs, bfrag, cfrag, abr, abi, hre, him, tok0, nchunks, g);
    if (!lat) {
      const size_t so = ((((size_t)b * 2 + j) * 2 + dir) * 64 + g) * 64 + lane;
      P.out[OUT_SRE + so] = hre;
      P.out[OUT_SIM + so] = him;
    }
  }
}

DI void attn_phase(const Params& P, int j, char* smem) {
  const int tid = tidx(), lane = tid & 63, wv = tid >> 6, r31 = lane & 31, hh = lane >> 5;
  char* Ks = smem;
  char* Vt = smem + 9216;
  const bf16* qbuf = (const bf16*)(P.ws + WS_U);
  const bf16* kbuf = (const bf16*)(P.ws + WS_YF);
  const bf16* vbuf = (const bf16*)(P.ws + WS_YB);
  const bf16* ck = (const bf16*)(P.ws + WS_CK);
  const bf16* cv = (const bf16*)(P.ws + WS_CV);
  bf16* zbuf = (bf16*)(P.ws + WS_Z);
  for (int item = blockIdx.x; item < 5120; item += gridDim.x) {
    const bool lat = item < 4096;
    int qb, head, b, tokq0;
    if (lat) { qb = item & 31; head = (item >> 5) & 15; b = item >> 9; tokq0 = NCTX + b * 4096 + qb * 128; }
    else { const int it = item - 4096; qb = it & 1; head = (it >> 1) & 15; b = it >> 5; tokq0 = b * 256 + qb * 128; }
    const int kvh = head >> 2;
    const int qtok = tokq0 + wv * 32 + r31;
    constexpr float QSC = 0.125f * 1.4426950408889634f;
    bf16x8 qf[4];
#pragma unroll
    for (int s = 0; s < 4; ++s) {
      const u32x4 qr = *(const u32x4*)(qbuf + (size_t)qtok * 1024 + head * 64 + 16 * s + 8 * hh);
      qf[s] = __builtin_bit_cast(bf16x8, u32x4{pack_bf16(bf_lo(qr[0]) * QSC, bf_hi(qr[0]) * QSC), pack_bf16(bf_lo(qr[1]) * QSC, bf_hi(qr[1]) * QSC),
                                                 pack_bf16(bf_lo(qr[2]) * QSC, bf_hi(qr[2]) * QSC), pack_bf16(bf_lo(qr[3]) * QSC, bf_hi(qr[3]) * QSC)});
    }
    float m = P.attn_sink[j * 16 + head] * 1.4426950408889634f;
    float lsum = hh == 0 ? 1.f : 0.f;
    f32x16 o[2];
#pragma unroll
    for (int i = 0; i < 16; ++i) { o[0][i] = 0.f; o[1][i] = 0.f; }
    int t_lo = 0, t_hi = 4;
    if (lat) {
      const int w0 = qb * 128 - 128;
      const int first = w0 < 0 ? 10 : 8;
      int last = 14;
      while (w0 + (last - 1 - 8) * 64 >= 4096) --last;
      t_lo = 0; t_hi = last;
      (void)first;
    }
    auto tile_info = [&](int tile, const bf16*& kb, const bf16*& vb, bool& masked, int& kpos0) -> bool {
      masked = false; kpos0 = 0;
      if (lat) {
        if (tile < 8) {
          const size_t off = (((size_t)b * 2 + j) * 512 + tile * 64) * 256 + kvh * 64;
          kb = ck + off; vb = cv + off;
        } else {
          kpos0 = qb * 128 - 128 + (tile - 8) * 64;
          if (kpos0 < 0 || kpos0 >= 4096) return false;
          masked = true;
          const size_t off = ((size_t)NCTX + b * 4096 + kpos0) * 256 + kvh * 64;
          kb = kbuf + off; vb = vbuf + off;
        }
      } else {
        const size_t off = ((size_t)b * 256 + tile * 64) * 256 + kvh * 64;
        kb = kbuf + off; vb = vbuf + off;
      }
      return true;
    };
    u32x4 pk[2], pv[2];
    auto prefetch = [&](int tile) {
      const bf16 *kb, *vb; bool mk; int kp;
      if (tile < t_hi && tile_info(tile, kb, vb, mk, kp)) {
#pragma unroll
        for (int i = 0; i < 2; ++i) {
          const int c = tid + 256 * i, key = c >> 3, dc = c & 7;
          pk[i] = *(const u32x4*)(kb + (size_t)key * 256 + dc * 8);
          pv[i] = *(const u32x4*)(vb + (size_t)key * 256 + dc * 8);
        }
      }
    };
    prefetch(t_lo);
    for (int tile = t_lo; tile < t_hi; ++tile) {
      const bf16 *kb, *vb;
      bool masked;
      int kpos0;
      if (!tile_info(tile, kb, vb, masked, kpos0)) { prefetch(tile + 1); continue; }
      __syncthreads();
#pragma unroll
      for (int i = 0; i < 2; ++i) {
        const int c = tid + 256 * i, key = c >> 3, dc = c & 7;
        const u32x4 kk = pk[i], vv = pv[i];
        *(u32x4*)(Ks + key * 144 + dc * 16) = kk;
#pragma unroll
        for (int e = 0; e < 4; ++e) {
          *(bf16*)(Vt + (dc * 8 + 2 * e) * 144 + key * 2) = (bf16)(vv[e] & 0xffffu);
          *(bf16*)(Vt + (dc * 8 + 2 * e + 1) * 144 + key * 2) = (bf16)(vv[e] >> 16);
        }
      }
      __syncthreads();
      prefetch(tile + 1);
      f32x16 sacc[2];
#pragma unroll
      for (int i = 0; i < 16; ++i) { sacc[0][i] = 0.f; sacc[1][i] = 0.f; }
#pragma unroll
      for (int mb = 0; mb < 2; ++mb)
#pragma unroll
        for (int s = 0; s < 4; ++s) {
          const bf16x8 a = *(const bf16x8*)(Ks + (mb * 32 + r31) * 144 + s * 32 + hh * 16);
          sacc[mb] = MFMA32(a, qf[s], sacc[mb]);
        }
      float mx = m;
      const int qp = qb * 128 + wv * 32 + r31;
#pragma unroll
      for (int mb = 0; mb < 2; ++mb)
#pragma unroll
        for (int i = 0; i < 16; ++i) {
          float v = sacc[mb][i];
          if (masked) {
            const int dlt = kpos0 + mb * 32 + crow(i, hh) - qp;
            v = (dlt >= -128 && dlt <= 128) ? v : -1e30f;
          }
          sacc[mb][i] = v;
          mx = fmaxf(mx, v);
        }
      mx = fmaxf(mx, __shfl_xor(mx, 32));
      const float alpha = __builtin_amdgcn_exp2f(m - mx);
      if (__builtin_amdgcn_ballot_w64(mx != m) != 0) {
        lsum *= alpha;
#pragma unroll
        for (int i = 0; i < 16; ++i) { o[0][i] *= alpha; o[1][i] *= alpha; }
      }
      m = mx;
#pragma unroll
      for (int mb = 0; mb < 2; ++mb)
#pragma unroll
        for (int i = 0; i < 16; ++i) { const float p = __builtin_amdgcn_exp2f(sacc[mb][i] - mx); sacc[mb][i] = p; lsum += p; }
#pragma unroll
      for (int mb = 0; mb < 2; ++mb)
#pragma unroll
        for (int s2 = 0; s2 < 2; ++s2) {
          const u32x4 pw = u32x4{pack_bf16(sacc[mb][8 * s2 + 0], sacc[mb][8 * s2 + 1]), pack_bf16(sacc[mb][8 * s2 + 2], sacc[mb][8 * s2 + 3]),
                                 pack_bf16(sacc[mb][8 * s2 + 4], sacc[mb][8 * s2 + 5]), pack_bf16(sacc[mb][8 * s2 + 6], sacc[mb][8 * s2 + 7])};
          const bf16x8 pf = __builtin_bit_cast(bf16x8, pw);
#pragma unroll
          for (int db = 0; db < 2; ++db) {
            const char* vp = Vt + (db * 32 + r31) * 144 + (mb * 32 + 16 * s2 + 4 * hh) * 2;
            const u32x2 lo = *(const u32x2*)vp, hi = *(const u32x2*)(vp + 16);
            const bf16x8 a = __builtin_bit_cast(bf16x8, u32x4{lo[0], lo[1], hi[0], hi[1]});
            o[db] = MFMA32(a, pf, o[db]);
          }
        }
    }
    const float ltot = lsum + __shfl_xor(lsum, 32);
    const float inv = 1.f / ltot;
#pragma unroll
    for (int db = 0; db < 2; ++db)
#pragma unroll
      for (int g4 = 0; g4 < 4; ++g4) {
        const u32x2 w = u32x2{pack_bf16(o[db][4 * g4] * inv, o[db][4 * g4 + 1] * inv), pack_bf16(o[db][4 * g4 + 2] * inv, o[db][4 * g4 + 3] * inv)};
        *(u32x2*)(zbuf + (size_t)qtok * 1024 + head * 64 + db * 32 + 8 * g4 + 4 * hh) = w;
      }
  }
}

DI void ln_phase(const Params& P, int layer, int which) {
  const int lane = tidx() & 63, wv = tidx() >> 6;
  const bool last = which == 1 && layer == DEPTH - 1;
  const float* mod = (const float*)(P.ws + WS_MOD) + (size_t)(layer + which) * 9 * 6144 + (which ? 0 : 3 * 1024);
  bf16* x = (bf16*)(P.ws + WS_X);
  bf16* h = (bf16*)(P.ws + WS_H);
  const float* lg = P.ln_g + (size_t)(layer * 2 + which) * 1024;
  const float* lb = P.ln_b + (size_t)(layer * 2 + which) * 1024;
  const int tstride = gridDim.x * 4;
  u32x2 nx[4];
  {
    const int t0 = blockIdx.x * 4 + wv;
    if (t0 < NTOK) {
#pragma unroll
      for (int c = 0; c < 4; ++c) nx[c] = *(const u32x2*)(x + (size_t)t0 * D + c * 256 + lane * 4);
    }
  }
  for (int tok = blockIdx.x * 4 + wv; tok < NTOK; tok += tstride) {
    bf16* xr = x + (size_t)tok * D;
    float v[16];
#pragma unroll
    for (int c = 0; c < 4; ++c) { const f32x4 t = unpack4(nx[c]); v[4 * c] = t[0]; v[4 * c + 1] = t[1]; v[4 * c + 2] = t[2]; v[4 * c + 3] = t[3]; }
    if (tok + tstride < NTOK) {
#pragma unroll
      for (int c = 0; c < 4; ++c) nx[c] = *(const u32x2*)(x + (size_t)(tok + tstride) * D + c * 256 + lane * 4);
    }
    float s = 0.f;
#pragma unroll
    for (int e = 0; e < 16; ++e) s += v[e];
    const float mu = wave_sum(s) * (1.f / 1024.f);
    float q = 0.f;
#pragma unroll
    for (int e = 0; e < 16; ++e) { const float d = v[e] - mu; q += d * d; }
    const float rstd = rsqrtf(wave_sum(q) * (1.f / 1024.f) + LN_EPS);
    const float* m = mod + (size_t)cond_of(tok) * 6144;
#pragma unroll
    for (int c = 0; c < 4; ++c) {
      const int col = c * 256 + lane * 4;
      const f32x4 g4 = *(const f32x4*)(lg + col), b4 = *(const f32x4*)(lb + col);
      f32x4 y;
#pragma unroll
      for (int e = 0; e < 4; ++e) y[e] = (v[4 * c + e] - mu) * rstd * g4[e] + b4[e];
      if (last) { *(f32x4*)(P.out + OUT_Y + (size_t)tok * D + col) = y; continue; }
      const f32x4 sh = *(const f32x4*)(m + col), sc = *(const f32x4*)(m + 1024 + col);
      float hv[4];
#pragma unroll
      for (int e = 0; e < 4; ++e) hv[e] = y[e] * (1.f + sc[e]) + sh[e];
      *(u32x2*)(xr + col) = u32x2{pack_bf16(y[0], y[1]), pack_bf16(y[2], y[3])};
      *(u32x2*)(h + (size_t)tok * D + col) = u32x2{pack_bf16(hv[0], hv[1]), pack_bf16(hv[2], hv[3])};
    }
  }
}

DI void route_phase(const Params& P, int layer, char* smem) {
  const int tid = tidx(), lane = tid & 63, wv = tid >> 6, r31 = lane & 31, hh = lane >> 5;
  const bf16* hbuf = (const bf16*)(P.ws + WS_H);
  const bf16* wq = (const bf16*)(P.ws + WS_WQ) + (size_t)layer * 2097152;
  const bf16* keys = (const bf16*)(P.ws + WS_KEYS);
  int* idxo = (int*)(P.ws + WS_IDX);
  float* go = (float*)(P.ws + WS_G);
  f32x16 zero;
#pragma unroll
  for (int i = 0; i < 16; ++i) zero[i] = 0.f;
  const int xcd = blockIdx.x & 7, lb = blockIdx.x >> 3, nlb = (gridDim.x + 7 - xcd) >> 3;
  const int ntx = (320 - xcd + 7) >> 3;
  for (int item = lb; item < ntx * 8; item += nlb) {
    const int tm = xcd + 8 * (item >> 3), head = item & 7;
    const int hmask = -hh;
    int t1[16], t2[16];
    for (int half = 0; half < 2; ++half) {
      f32x16 acc[4][1];
      PlainLoad al{wq + ((size_t)head * 256 + half * 128) * 1024, 1024};
      PlainLoad bl{hbuf + (size_t)tm * 128 * 1024, 1024};
      const bf16* kbase = keys + ((((size_t)layer * 2 + half) * 8 + head) * 128) * 128;
      u32x4 kreg[8];
#pragma unroll
      for (int i = 0; i < 8; ++i) { const int c = tid + 256 * i; kreg[i] = *(const u32x4*)(kbase + (size_t)(c >> 4) * 128 + (c & 15) * 8); }
      mainloop<4, 1>(acc, al, bl, 1024, smem, 0, wv * 32);
#pragma unroll
      for (int i = 0; i < 8; ++i) { const int c = tid + 256 * i; *(u32x4*)(smem + (c >> 4) * 272 + (c & 15) * 16) = kreg[i]; }
      __syncthreads();
      bf16x8 qf[4][2];
#pragma unroll
      for (int mb = 0; mb < 4; ++mb)
#pragma unroll
        for (int s2 = 0; s2 < 2; ++s2) {
          const f32x16& a = acc[mb][0];
          qf[mb][s2] = __builtin_bit_cast(bf16x8, u32x4{pack_bf16(a[8 * s2 + 0], a[8 * s2 + 1]), pack_bf16(a[8 * s2 + 2], a[8 * s2 + 3]),
                                                         pack_bf16(a[8 * s2 + 4], a[8 * s2 + 5]), pack_bf16(a[8 * s2 + 6], a[8 * s2 + 7])});
        }
      int v[64];
#pragma unroll
      for (int kb = 0; kb < 4; ++kb) {
        f32x16 sc = zero;
#pragma unroll
        for (int mb = 0; mb < 4; ++mb)
#pragma unroll
          for (int s2 = 0; s2 < 2; ++s2) {
            const char* kp = smem + (kb * 32 + r31) * 272 + (mb * 32 + 16 * s2 + 4 * hh) * 2;
            const u32x2 lo = *(const u32x2*)kp, hi = *(const u32x2*)(kp + 16);
            const bf16x8 a = __builtin_bit_cast(bf16x8, u32x4{lo[0], lo[1], hi[0], hi[1]});
            sc = MFMA32(a, qf[mb][s2], sc);
          }
#pragma unroll
        for (int i = 0; i < 16; ++i) {
          const int key = kb * 32 + crow(i, hh);
          v[kb * 16 + i] = f2key(__int_as_float((__float_as_int(sc[i]) & ~0x7f) | key));
        }
      }
      __syncthreads();
      sort16_desc<64, 0>(v); sort16_desc<64, 16>(v); sort16_desc<64, 32>(v); sort16_desc<64, 48>(v);
      merge16_desc<64, 0, 16>(v); merge16_desc<64, 32, 48>(v); merge16_desc<64, 0, 32>(v);
      pair_merge16<64>(v);
      if (half == 0) {
#pragma unroll
        for (int i = 0; i < 16; ++i) t1[i] = key2bits(v[i]);
      } else {
#pragma unroll
        for (int i = 0; i < 16; ++i) t2[i] = key2bits(v[i]);
      }
    }
    int cd[32];
    {
      int ce[25], co[25];
      int cnt = 0;
#pragma unroll
      for (int a = 0; a < 16; ++a)
#pragma unroll
        for (int bq = 0; bq < 16; ++bq) {
          if ((a + 1) * (bq + 1) <= 16) {
            const float sum = __int_as_float(t1[a] & ~0x7f) + __int_as_float(t2[bq] & ~0x7f);
            const int kk = f2key(__int_as_float((__float_as_int(sum) & ~0xff) | (a * 16 + bq)));
            if ((cnt & 1) == 0) ce[cnt >> 1] = kk; else co[cnt >> 1] = kk;
            ++cnt;
          }
        }
#pragma unroll
      for (int s = 0; s < 25; ++s) cd[s] = bsel(hmask, ce[s], co[s]);
#pragma unroll
      for (int s = 25; s < 32; ++s) cd[s] = (int)0x80000000;
    }
    sort16_desc<32, 0>(cd); sort16_desc<32, 16>(cd);
    merge16_desc<32, 0, 16>(cd);
    pair_merge16<32>(cd);
    unsigned char* tab = (unsigned char*)smem + wv * 1024;
    {
      unsigned w[4];
#pragma unroll
      for (int e = 0; e < 4; ++e) {
        const unsigned b0 = (unsigned)(bsel(hmask, t1[4 * e], t2[4 * e]) & 0x7f), b1 = (unsigned)(bsel(hmask, t1[4 * e + 1], t2[4 * e + 1]) & 0x7f);
        const unsigned b2 = (unsigned)(bsel(hmask, t1[4 * e + 2], t2[4 * e + 2]) & 0x7f), b3 = (unsigned)(bsel(hmask, t1[4 * e + 3], t2[4 * e + 3]) & 0x7f);
        w[e] = b0 | (b1 << 8) | (b2 << 16) | (b3 << 24);
      }
      *(u32x4*)(tab + r31 * 32 + hh * 16) = u32x4{w[0], w[1], w[2], w[3]};
    }
    wave_fence();
    float vals[16]; int eidx[16];
    float ssum = 0.f;
    const float v0 = __int_as_float(key2bits(cd[0]) & ~0xff);
#pragma unroll
    for (int r = 0; r < 16; ++r) {
      const int bits = key2bits(cd[r]);
      const int code = bits & 0xff;
      const int i1 = tab[r31 * 32 + (code >> 4)], i2 = tab[r31 * 32 + 16 + (code & 15)];
      eidx[r] = i1 * 128 + i2;
      vals[r] = __expf(__int_as_float(bits & ~0xff) - v0);
      ssum += vals[r];
    }
    const float inv = 1.f / ssum;
    const int tok = tm * 128 + wv * 32 + r31;
    int ei[8]; float gv[8];
#pragma unroll
    for (int r = 0; r < 8; ++r) { ei[r] = bsel(hmask, eidx[r], eidx[8 + r]); gv[r] = __int_as_float(bsel(hmask, __float_as_int(vals[r]), __float_as_int(vals[8 + r]))) * inv; }
    const size_t ob = ((size_t)tok * 8 + head) * 16 + 8 * hh;
    *(u32x4*)(idxo + ob) = u32x4{(unsigned)ei[0], (unsigned)ei[1], (unsigned)ei[2], (unsigned)ei[3]};
    *(u32x4*)(idxo + ob + 4) = u32x4{(unsigned)ei[4], (unsigned)ei[5], (unsigned)ei[6], (unsigned)ei[7]};
    *(f32x4*)(go + ob) = f32x4{gv[0], gv[1], gv[2], gv[3]};
    *(f32x4*)(go + ob + 4) = f32x4{gv[4], gv[5], gv[6], gv[7]};
    __syncthreads();
  }
}

DI float dpp_f(float x, const int ctrl_sel) {
  const int xi = __float_as_int(x);
  int r;
  if (ctrl_sel == 0) r = __builtin_amdgcn_update_dpp(0, xi, 0xB1, 0xf, 0xf, false);
  else if (ctrl_sel == 1) r = __builtin_amdgcn_update_dpp(0, xi, 0x4E, 0xf, 0xf, false);
  else if (ctrl_sel == 2) r = __builtin_amdgcn_update_dpp(0, xi, 0x141, 0xf, 0xf, false);
  else r = __builtin_amdgcn_update_dpp(0, xi, 0x140, 0xf, 0xf, false);
  return __int_as_float(r);
}
DI float row16_sum(float s) { s += dpp_f(s, 0); s += dpp_f(s, 1); s += dpp_f(s, 2); s += dpp_f(s, 3); return s; }

DI float row8_sum(float s) { s += dpp_f(s, 0); s += dpp_f(s, 1); s += dpp_f(s, 2); return s; }
DI float ror8_add(float x) { return x + __int_as_float(__builtin_amdgcn_update_dpp(0, __float_as_int(x), 0x128, 0xf, 0xf, false)); }

DI fl2_t dec4(unsigned w, int b) {
  if (b == 0) return __builtin_amdgcn_cvt_scalef32_pk_f32_fp4(w, 1.0f, 0);
  if (b == 1) return __builtin_amdgcn_cvt_scalef32_pk_f32_fp4(w, 1.0f, 1);
  if (b == 2) return __builtin_amdgcn_cvt_scalef32_pk_f32_fp4(w, 1.0f, 2);
  return __builtin_amdgcn_cvt_scalef32_pk_f32_fp4(w, 1.0f, 3);
}
constexpr float PEER_HS = 2.f;
typedef __attribute__((ext_vector_type(8))) int i32x8;
struct UAux { u32x4 h; float p0, p1, g0, g1; };
DI void gatherU_phase(const Params& P, int layer, char* smem) {
  const int lane = tidx() & 63, wv = tidx() >> 6, rg = lane >> 3, cl = lane & 7, r16 = lane & 15, q = lane >> 4;
  const bf16* h = (const bf16*)(P.ws + WS_H);
  const unsigned char* ut = (const unsigned char*)(P.ws + WS_PU) + (size_t)layer * 4 * 16384 * 128;
  const int* idx = (const int*)(P.ws + WS_IDX);
  const float* gg = (const float*)(P.ws + WS_G);
  float* act = (float*)(P.ws + WS_ACT);
  char* T = smem + wv * 18432;
  int* s_idx = (int*)(smem + wv * 18432 + 17408);
  float* s_part = (float*)(smem + wv * 18432 + 17920);
  const int gw = blockIdx.x * 4 + wv, nw = gridDim.x * 4;
  const int K = gw < NTOK ? (NTOK - 1 - gw) / nw + 1 : 0;
  for (int c = 0; c < 4; ++c) {
    const unsigned char* uts = ut + (size_t)c * 16384 * 128 + cl * 16;
    auto load_idx = [&](int tok, int& i0, int& i1) { i0 = idx[(size_t)tok * 128 + lane]; i1 = idx[(size_t)tok * 128 + 64 + lane]; };
    auto load_aux = [&](UAux& ax, int tok) {
      ax.h = *(const u32x4*)(h + (size_t)tok * D + c * 256 + ((r16 & 7) >> 2) * 128 + q * 32 + (r16 & 3) * 8);
      ax.p0 = 0.f; ax.p1 = 0.f; ax.g0 = 0.f; ax.g1 = 0.f;
      if (c > 0) {
        ax.p0 = __hip_atomic_load(act + (size_t)tok * 128 + lane, __ATOMIC_RELAXED, __HIP_MEMORY_SCOPE_AGENT);
        ax.p1 = __hip_atomic_load(act + (size_t)tok * 128 + 64 + lane, __ATOMIC_RELAXED, __HIP_MEMORY_SCOPE_AGENT);
      }
      if (c == 3) { ax.g0 = gg[(size_t)tok * 128 + lane]; ax.g1 = gg[(size_t)tok * 128 + 64 + lane]; }
    };
    auto compute = [&](const u32x4(&rows)[16], const UAux& ax, int tok) {
      i32x8 hb1[2], hb2[2];
      {
        const u32x4 hv = ax.h;
        unsigned w1 = 0, w2 = 0;
#pragma unroll
        for (int e = 0; e < 4; ++e) {
          const float f0 = bf_lo(hv[e]) * PEER_HS, f1 = bf_hi(hv[e]) * PEER_HS;
          if (e == 0) w1 = __builtin_amdgcn_cvt_scalef32_pk_fp4_f32(w1, f0, f1, 1.0f, 0);
          else if (e == 1) w1 = __builtin_amdgcn_cvt_scalef32_pk_fp4_f32(w1, f0, f1, 1.0f, 1);
          else if (e == 2) w1 = __builtin_amdgcn_cvt_scalef32_pk_fp4_f32(w1, f0, f1, 1.0f, 2);
          else w1 = __builtin_amdgcn_cvt_scalef32_pk_fp4_f32(w1, f0, f1, 1.0f, 3);
        }
#pragma unroll
        for (int e = 0; e < 4; ++e) {
          const fl2_t d = dec4(w1, e);
          const float r0 = (bf_lo(hv[e]) * PEER_HS - d[0]) * 4.f, r1 = (bf_hi(hv[e]) * PEER_HS - d[1]) * 4.f;
          if (e == 0) w2 = __builtin_amdgcn_cvt_scalef32_pk_fp4_f32(w2, r0, r1, 1.0f, 0);
          else if (e == 1) w2 = __builtin_amdgcn_cvt_scalef32_pk_fp4_f32(w2, r0, r1, 1.0f, 1);
          else if (e == 2) w2 = __builtin_amdgcn_cvt_scalef32_pk_fp4_f32(w2, r0, r1, 1.0f, 2);
          else w2 = __builtin_amdgcn_cvt_scalef32_pk_fp4_f32(w2, r0, r1, 1.0f, 3);
        }
        unsigned* s_h = (unsigned*)s_idx;
        wave_fence();
        s_h[q * 16 + r16] = r16 < 8 ? w1 : w2;
        wave_fence();
        const u32x4 a0 = *(const u32x4*)(s_h + q * 16), a1 = *(const u32x4*)(s_h + q * 16 + 4);
        const u32x4 b0 = *(const u32x4*)(s_h + q * 16 + 8), b1 = *(const u32x4*)(s_h + q * 16 + 12);
        hb1[0] = i32x8{(int)a0[0], (int)a0[1], (int)a0[2], (int)a0[3], 0, 0, 0, 0};
        hb1[1] = i32x8{(int)a1[0], (int)a1[1], (int)a1[2], (int)a1[3], 0, 0, 0, 0};
        hb2[0] = i32x8{(int)b0[0], (int)b0[1], (int)b0[2], (int)b0[3], 0, 0, 0, 0};
        hb2[1] = i32x8{(int)b1[0], (int)b1[1], (int)b1[2], (int)b1[3], 0, 0, 0, 0};
      }
      wave_fence();
#pragma unroll
      for (int rb = 0; rb < 16; ++rb) {
        char* tp = T + (rb * 8 + rg) * 136 + cl * 16;
        *(u32x2*)tp = u32x2{rows[rb][0], rows[rb][1]};
        *(u32x2*)(tp + 8) = u32x2{rows[rb][2], rows[rb][3]};
      }
      wave_fence();
#pragma unroll
      for (int mt = 0; mt < 8; ++mt) {
        f32x4 acc = {0.f, 0.f, 0.f, 0.f};
#pragma unroll
        for (int s2 = 0; s2 < 2; ++s2) {
          const char* tp = T + (mt * 16 + r16) * 136 + s2 * 64 + q * 16;
          const u32x2 lo = *(const u32x2*)tp, hi = *(const u32x2*)(tp + 8);
          const i32x8 av = {(int)lo[0], (int)lo[1], (int)hi[0], (int)hi[1], 0, 0, 0, 0};
          acc = __builtin_amdgcn_mfma_scale_f32_16x16x128_f8f6f4(av, hb1[s2], acc, 4, 4, 0, 127, 0, 127);
          acc = __builtin_amdgcn_mfma_scale_f32_16x16x128_f8f6f4(av, hb2[s2], acc, 4, 4, 0, 127, 0, 125);
        }
        if (r16 == 0) *(f32x4*)(s_part + mt * 16 + 4 * q) = acc;
      }
      wave_fence();
      float v0 = s_part[lane] * (1.f / PEER_HS) + ax.p0, v1 = s_part[64 + lane] * (1.f / PEER_HS) + ax.p1;
      if (c == 3) {
        v0 = gelu_tanh(v0 * (1.f / PEER_SU)) * ax.g0 * (1.f / PEER_SV);
        v1 = gelu_tanh(v1 * (1.f / PEER_SU)) * ax.g1 * (1.f / PEER_SV);
      }
      act[(size_t)tok * 128 + lane] = v0;
      act[(size_t)tok * 128 + 64 + lane] = v1;
    };
    if (K == 0) continue;
    u32x4 rA[16];
    UAux xA, xN;
    int i0, i1;
    load_idx(gw, i0, i1);
    load_aux(xN, gw);
#pragma unroll 1
    for (int k = 0; k < K; ++k) {
      const int tok = gw + k * nw;
      xA = xN;
      wave_fence();
      s_idx[lane] = i0; s_idx[64 + lane] = i1;
      wave_fence();
#pragma unroll
      for (int rb = 0; rb < 16; ++rb) { const int e = s_idx[rb * 8 + rg]; rA[rb] = *(const u32x4*)(uts + (size_t)e * 128); }
      if (k + 1 < K) { load_idx(tok + nw, i0, i1); load_aux(xN, tok + nw); }
      compute(rA, xA, tok);
    }
  }
}

constexpr float PEER_XS = 2.f * PEER_SV;
typedef __attribute__((ext_vector_type(2))) int i32x2;
typedef __attribute__((address_space(3))) i32x2* lds_i32x2_ptr;
struct VAux { float a0, a1; f32x4 xv, gt; };
DI unsigned enc4x8(const float (&x)[8]) {
  unsigned w = 0;
  w = __builtin_amdgcn_cvt_scalef32_pk_fp4_f32(w, x[0], x[1], 1.0f, 0);
  w = __builtin_amdgcn_cvt_scalef32_pk_fp4_f32(w, x[2], x[3], 1.0f, 1);
  w = __builtin_amdgcn_cvt_scalef32_pk_fp4_f32(w, x[4], x[5], 1.0f, 2);
  w = __builtin_amdgcn_cvt_scalef32_pk_fp4_f32(w, x[6], x[7], 1.0f, 3);
  return w;
}
DI void resid4x8(float (&x)[8], unsigned w) {
#pragma unroll
  for (int e = 0; e < 4; ++e) { const fl2_t d = dec4(w, e); x[2 * e] = (x[2 * e] - d[0]) * 4.f; x[2 * e + 1] = (x[2 * e + 1] - d[1]) * 4.f; }
}
DI void gatherV_phase(const Params& P, int layer, char* smem) {
  const int lane = tidx() & 63, wv = tidx() >> 6, rg = lane >> 3, cl = lane & 7, r16 = lane & 15, q = lane >> 4;
  const float* mod = (const float*)(P.ws + WS_MOD) + (size_t)layer * 9 * 6144 + 5 * 1024;
  bf16* x = (bf16*)(P.ws + WS_X);
  const unsigned char* vt = (const unsigned char*)(P.ws + WS_PV) + (size_t)layer * 4 * 16384 * 128;
  const int* idx = (const int*)(P.ws + WS_IDX);
  const float* act = (const float*)(P.ws + WS_ACT);
  char* T = smem + wv * 18432;
  int* s_idx = (int*)(smem + wv * 18432 + 17408);
  float* s_act = (float*)(smem + wv * 18432 + 17920);
  const int gw = blockIdx.x * 4 + wv, nw = gridDim.x * 4;
  const int K = gw < NTOK ? (NTOK - 1 - gw) / nw + 1 : 0;
  for (int c = 0; c < 4; ++c) {
    const unsigned char* vts = vt + (size_t)c * 16384 * 128 + cl * 16;
    auto load_tok = [&](int tok, int& i0, int& i1, VAux& ax) {
      i0 = idx[(size_t)tok * 128 + lane]; i1 = idx[(size_t)tok * 128 + 64 + lane];
      ax.a0 = act[(size_t)tok * 128 + lane]; ax.a1 = act[(size_t)tok * 128 + 64 + lane];
      ax.xv = unpack4(*(const u32x2*)(x + (size_t)tok * D + c * 256 + 4 * lane));
      ax.gt = *(const f32x4*)(mod + (size_t)cond_of(tok) * 6144 + c * 256 + 4 * lane);
    };
    if (K == 0) continue;
    u32x4 rows[16];
    VAux xA, xN;
    int i0, i1;
    load_tok(gw, i0, i1, xN);
#pragma unroll 1
    for (int k = 0; k < K; ++k) {
      const int tok = gw + k * nw;
      xA = xN;
      wave_fence();
      s_idx[lane] = i0; s_idx[64 + lane] = i1;
      s_act[lane] = xA.a0; s_act[64 + lane] = xA.a1;
      wave_fence();
#pragma unroll
      for (int rb = 0; rb < 16; ++rb) { const int e = s_idx[rb * 8 + rg]; rows[rb] = *(const u32x4*)(vts + (size_t)e * 128); }
      if (k + 1 < K) load_tok(tok + nw, i0, i1, xN);
      i32x8 a1v, a2v, a3v, a4v;
      {
        float xv8[8];
        const int d = r16 & 3, term = r16 >> 2;
        const f32x4 s0 = *(const f32x4*)(s_act + 32 * q + 8 * d), s1 = *(const f32x4*)(s_act + 32 * q + 8 * d + 4);
#pragma unroll
        for (int e = 0; e < 4; ++e) { xv8[e] = s0[e] * PEER_XS; xv8[4 + e] = s1[e] * PEER_XS; }
        unsigned w = enc4x8(xv8);
        if (term >= 1) { resid4x8(xv8, w); w = enc4x8(xv8); }
        if (term >= 2) { resid4x8(xv8, w); w = enc4x8(xv8); }
        if (term >= 3) { resid4x8(xv8, w); w = enc4x8(xv8); }
        unsigned* s_h = (unsigned*)s_idx;
        wave_fence();
        s_h[q * 16 + term * 4 + d] = w;
        wave_fence();
        const unsigned* hp = s_h + q * 16;
        a1v = i32x8{(int)hp[0], (int)hp[1], (int)hp[2], (int)hp[3], 0, 0, 0, 0};
        a2v = i32x8{(int)hp[4], (int)hp[5], (int)hp[6], (int)hp[7], 0, 0, 0, 0};
        a3v = i32x8{(int)hp[8], (int)hp[9], (int)hp[10], (int)hp[11], 0, 0, 0, 0};
        a4v = i32x8{(int)hp[12], (int)hp[13], (int)hp[14], (int)hp[15], 0, 0, 0, 0};
      }
      wave_fence();
#pragma unroll
      for (int rb = 0; rb < 16; ++rb) {
        char* tp = T + (rb * 8 + rg) * 136 + cl * 16;
        *(u32x2*)tp = u32x2{rows[rb][0], rows[rb][1]};
        *(u32x2*)(tp + 8) = u32x2{rows[rb][2], rows[rb][3]};
      }
      wave_fence();
      float outv[16];
#pragma unroll
      for (int nt = 0; nt < 16; ++nt) {
        const i32x2 b01 = __builtin_amdgcn_ds_read_tr4_b64_v2i32((lds_i32x2_ptr)(T + (32 * q + r16) * 136 + nt * 8));
        const i32x2 b23 = __builtin_amdgcn_ds_read_tr4_b64_v2i32((lds_i32x2_ptr)(T + (32 * q + 16 + r16) * 136 + nt * 8));
        const i32x8 bv = {b01[0], b01[1], b23[0], b23[1], 0, 0, 0, 0};
        f32x4 acc = {0.f, 0.f, 0.f, 0.f};
        acc = __builtin_amdgcn_mfma_scale_f32_16x16x128_f8f6f4(a1v, bv, acc, 4, 4, 0, 127, 0, 127);
        acc = __builtin_amdgcn_mfma_scale_f32_16x16x128_f8f6f4(a2v, bv, acc, 4, 4, 0, 125, 0, 127);
        acc = __builtin_amdgcn_mfma_scale_f32_16x16x128_f8f6f4(a3v, bv, acc, 4, 4, 0, 123, 0, 127);
        acc = __builtin_amdgcn_mfma_scale_f32_16x16x128_f8f6f4(a4v, bv, acc, 4, 4, 0, 121, 0, 127);
        outv[nt] = acc[0];
      }
      wave_fence();
      float* s_out = (float*)T;
      if (q == 0) {
#pragma unroll
        for (int nt = 0; nt < 16; ++nt) s_out[nt * 16 + r16] = outv[nt];
      }
      wave_fence();
      const f32x4 sum = *(const f32x4*)(s_out + 4 * lane);
      f32x4 res;
#pragma unroll
      for (int e = 0; e < 4; ++e) res[e] = DN_ALPHA * xA.xv[e] + (1.f + xA.gt[e]) * sum[e] * (1.f / PEER_XS);
      *(u32x2*)(x + (size_t)tok * D + c * 256 + 4 * lane) = u32x2{pack_bf16(res[0], res[1]), pack_bf16(res[2], res[3])};
    }
  }
}

constexpr int ST_LD = 68;
constexpr int ST_WAVE_BYTES = 64 * ST_LD * 4;
template <class F>
DI void wave_tile_epilogue(f32x16 (&acc)[2][2], char* smem, const F& f) {
  const int lane = tidx() & 63, wv = tidx() >> 6, r31 = lane & 31, hh = lane >> 5;
  float* st = (float*)(smem + wv * ST_WAVE_BYTES);
#pragma unroll
  for (int mi = 0; mi < 2; ++mi)
#pragma unroll
    for (int ni = 0; ni < 2; ++ni)
#pragma unroll
      for (int i = 0; i < 16; ++i) st[(mi * 32 + crow(i, hh)) * ST_LD + ni * 32 + r31] = acc[mi][ni][i];
  wave_fence();
#pragma unroll 2
  for (int it = 0; it < 8; ++it) {
    const int row = it * 8 + (lane >> 3), c0 = (lane & 7) * 8;
    f(row, c0, (const float*)(st + row * ST_LD));
  }
}
DI void ld8(const float* p, float (&v)[8]) {
  const f32x4 a = *(const f32x4*)p, b = *(const f32x4*)(p + 4);
  v[0] = a[0]; v[1] = a[1]; v[2] = a[2]; v[3] = a[3]; v[4] = b[0]; v[5] = b[1]; v[6] = b[2]; v[7] = b[3];
}
DI void st8(float* p, const float (&v)[8]) {
  *(f32x4*)p = f32x4{v[0], v[1], v[2], v[3]};
  *(f32x4*)(p + 4) = f32x4{v[4], v[5], v[6], v[7]};
}
DI u32x4 pack8(const float (&v)[8]) { return u32x4{pack_bf16(v[0], v[1]), pack_bf16(v[2], v[3]), pack_bf16(v[4], v[5]), pack_bf16(v[6], v[7])}; }

#define XB_TMO      128
#define XB_XCNT(j)  (256  + 64 * (j))
#define XB_XSUB(j)  (1280 + 64 * (j))
#define XB_XGEN(j)  (2304 + 64 * (j))
#define XB_TOP      3328
#define XB_TOPGEN   3392
#define XCD_BAR_WORDS 3456
#define XB_SPIN_CAP (1u << 18)
#define LAS __attribute__((address_space(3)))
DI unsigned xb_ld(unsigned* p) { return __hip_atomic_load(p, __ATOMIC_RELAXED, __HIP_MEMORY_SCOPE_AGENT); }
DI unsigned xb_add(unsigned* p, unsigned v) { return __hip_atomic_fetch_add(p, v, __ATOMIC_RELAXED, __HIP_MEMORY_SCOPE_AGENT); }
DI unsigned xb_xcc_id() { return (unsigned)__builtin_amdgcn_s_getreg((3 << 11) | 20) & 0xFu; }
#define XB_SPIN(cond, bar) do { unsigned _sp = 0; while (cond) { __builtin_amdgcn_s_sleep(1); \
    if ((++_sp & 255u) == 0u) { if (xb_ld(&(bar)[XB_TMO])) break; if (_sp > XB_SPIN_CAP) { atomicAdd(&(bar)[XB_TMO], 1u); break; } } } } while (0)
struct XcdBarrier { unsigned* bar; unsigned x; volatile LAS unsigned* st; };
DI XcdBarrier xcd_barrier_post(unsigned* bar, volatile LAS unsigned* st) {
  XcdBarrier b; b.bar = bar; b.x = xb_xcc_id(); b.st = st;
  if (__builtin_amdgcn_workitem_id_x() == 0) (void)xb_add(&bar[XB_XCNT(b.x)], 1u);
  return b;
}
DI void xcd_barrier_complete(unsigned* bar, unsigned x, unsigned& nloc, unsigned& nx) {
  const unsigned G = gridDim.x * gridDim.y * gridDim.z;
  unsigned sum, cnt, mine, sp = 0u;
  for (;;) {
    sum = 0u; cnt = 0u; mine = 0u;
#pragma unroll
    for (unsigned j = 0; j < 16; ++j) { const unsigned c = xb_ld(&bar[XB_XCNT(j)]); sum += c; cnt += (c > 0u) ? 1u : 0u; mine = (j == x) ? c : mine; }
    if (sum == G) break;
    __builtin_amdgcn_s_sleep(1);
    if ((++sp & 255u) == 0u) { if (xb_ld(&bar[XB_TMO])) break; if (sp > XB_SPIN_CAP) { atomicAdd(&bar[XB_TMO], 1u); break; } }
  }
  nloc = mine > 0u ? mine : 1u; nx = cnt > 0u ? cnt : 1u;
}
DI void xcd_barrier(const XcdBarrier& b) {
  asm volatile("s_waitcnt vmcnt(0)" ::: "memory");
  __syncthreads();
  if (__builtin_amdgcn_workitem_id_x() == 0) {
    unsigned* bar = b.bar;
    __builtin_amdgcn_s_waitcnt(0);
    unsigned nloc = b.st[0], nx = b.st[1];
    if (nloc == 0u) { xcd_barrier_complete(bar, b.x, nloc, nx); b.st[0] = nloc; b.st[1] = nx; }
    const unsigned old = xb_add(&bar[XB_XSUB(b.x)], 1u);
    const unsigned gen = old / nloc;
    if (old + 1u == (gen + 1u) * nloc) {
      __builtin_amdgcn_fence(__ATOMIC_RELEASE, "agent");
      asm volatile("s_waitcnt vmcnt(0)" ::: "memory");
      const unsigned og = xb_add(&bar[XB_TOP], 1u);
      const unsigned tg = og / nx;
      if (og + 1u == (tg + 1u) * nx) xb_add(&bar[XB_TOPGEN], 1u);
      else XB_SPIN(xb_ld(&bar[XB_TOPGEN]) == tg, bar);
      __builtin_amdgcn_fence(__ATOMIC_ACQUIRE, "agent");
      xb_add(&bar[XB_XGEN(b.x)], 1u);
      asm volatile("s_waitcnt vmcnt(0)" ::: "memory");
    } else {
      XB_SPIN(xb_ld(&bar[XB_XGEN(b.x)]) == gen, bar);
      __builtin_amdgcn_fence(__ATOMIC_ACQUIRE, "agent");
      asm volatile("s_waitcnt vmcnt(0)" ::: "memory");
    }
  }
  __syncthreads();
}

typedef const Params __attribute__((address_space(4)))* KParamPtr;
DI Params load_params() {
#if defined(__HIP_DEVICE_COMPILE__)
  KParamPtr kp = (KParamPtr)__builtin_amdgcn_kernarg_segment_ptr();
  asm volatile("" : "+s"(kp));
  return *kp;
#else
  return Params{};
#endif
}
__global__ void __launch_bounds__(256, 2) fwd_kernel(Params PK) {
  const int p0 = PK.p0, p1 = PK.p1;
  __shared__ __attribute__((aligned(16))) char smem[SMEM_BYTES];
  __shared__ uint4 xb_words;
  cg::grid_group grid = cg::this_grid();
  if (__builtin_amdgcn_workitem_id_x() == 0) xb_words = make_uint4(0u, 0u, 0u, 0u);
  __syncthreads();
  XcdBarrier xb;
  xb.bar = (unsigned*)(PK.ws + WS_BAR); xb.x = 0; xb.st = (volatile LAS unsigned*)&xb_words;
  if (p1 - p0 > 1) xb = xcd_barrier_post((unsigned*)(PK.ws + WS_BAR), (volatile LAS unsigned*)&xb_words);
  int ph = 0;
#ifndef SITEMASK
#define SITEMASK 0xFFFF
#endif
#define PH_BEGIN(id) if (((SITEMASK >> (id)) & 1) && ph >= p0 && ph < p1) { const Params P = load_params();
#define PH_END if (ph + 1 < p1) { if (ph == p0) { asm volatile("s_waitcnt vmcnt(0)" ::: "memory"); grid.sync(); } else xcd_barrier(xb); } } ++ph;
  PH_BEGIN(0) conv_phase(P, smem); PH_END
  PH_BEGIN(1) prep_phase(P); PH_END
  for (int layer = 0; layer < DEPTH; ++layer) {
    const int j = layer >> 1;
    if ((layer & 1) == 0) {
      PH_BEGIN(2) {
        bf16* ub = (bf16*)(P.ws + WS_U);
        auto epi = [&](f32x16(&acc)[2][2], int row0, int col0) {
          wave_tile_epilogue(acc, smem, [&](int row, int c0, const float* rp) {
            float v[8];
            ld8(rp + c0, v);
            *(u32x4*)(ub + (size_t)(row0 + row) * 1024 + col0 + c0) = pack8(v);
          });
        };
        gemm_phase(1024, PlainALF{(const bf16*)(P.ws + WS_H)}, (const bf16*)(P.ws + WS_WIN) + (size_t)j * 1048576, epi, smem);
      } PH_END
      PH_BEGIN(3) scan_phase(P, j, smem); PH_END
      PH_BEGIN(11) comb_phase(P, j); PH_END
      PH_BEGIN(4) {
        bf16* zb = (bf16*)(P.ws + WS_Z);
        auto epi = [&](f32x16(&acc)[2][2], int row0, int col0) {
          wave_tile_epilogue(acc, smem, [&](int row, int c0, const float* rp) {
            if (c0 < 32) {
              float v[8], g[8];
              ld8(rp + c0, v);
              ld8(rp + 32 + c0, g);
#pragma unroll
              for (int e = 0; e < 8; ++e) v[e] *= sigmoidf_(g[e]);
              *(u32x4*)(zb + (size_t)(row0 + row) * 1024 + (col0 >> 1) + c0) = pack8(v);
            }
          });
        };
        gemm_phase(2048, PlainALF{(const bf16*)(P.ws + WS_YF)}, (const bf16*)(P.ws + WS_WGLU) + (size_t)j * 2097152, epi, smem);
      } PH_END
    } else {
      PH_BEGIN(5) {
        bf16* qb = (bf16*)(P.ws + WS_U);
        bf16* kb = (bf16*)(P.ws + WS_YF);
        bf16* vb = (bf16*)(P.ws + WS_YB);
        const float* rt = (const float*)(P.ws + WS_ROPE);
        auto epi = [&](f32x16(&acc)[2][2], int row0, int col0) {
          const bool lat = row0 >= NCTX;
          wave_tile_epilogue(acc, smem, [&](int row, int c0, const float* rp) {
            const int tok = row0 + row;
            float v[8];
            ld8(rp + c0, v);
            if (lat && col0 < 1280) {
              const int pos = (tok - NCTX) & 4095;
              const int pp = (c0 & 32) ? (pos & 63) : (pos >> 6);
              const bool second = (c0 & 16) != 0;
              float o[8], cs[8], sn[8];
              ld8(rp + (second ? c0 - 16 : c0 + 16), o);
              ld8(rt + pp * 16 + (c0 & 15), cs);
              ld8(rt + 1024 + pp * 16 + (c0 & 15), sn);
#pragma unroll
              for (int e = 0; e < 8; ++e) v[e] = second ? (o[e] * sn[e] + v[e] * cs[e]) : (v[e] * cs[e] - o[e] * sn[e]);
            }
            if (col0 < 1024) {
              *(u32x4*)(qb + (size_t)tok * 1024 + col0 + c0) = pack8(v);
            } else if (col0 < 1280) {
              *(u32x4*)(kb + (size_t)tok * 256 + col0 - 1024 + c0) = pack8(v);
              if (!lat) st8(P.out + OUT_CK + (((size_t)(tok >> 8) * 2 + j) * 256 + (tok & 255)) * 256 + col0 - 1024 + c0, v);
            } else {
              *(u32x4*)(vb + (size_t)tok * 256 + col0 - 1280 + c0) = pack8(v);
              if (!lat) st8(P.out + OUT_CV + (((size_t)(tok >> 8) * 2 + j) * 256 + (tok & 255)) * 256 + col0 - 1280 + c0, v);
            }
          });
        };
        gemm_phase(1536, PlainALF{(const bf16*)(P.ws + WS_H)}, (const bf16*)(P.ws + WS_WQKV) + (size_t)j * 1572864, epi, smem);
      } PH_END
      PH_BEGIN(6) attn_phase(P, j, smem); PH_END
    }
    PH_BEGIN(7) {
      const float* mod = (const float*)(P.ws + WS_MOD) + (size_t)layer * 9 * 6144;
      bf16* xbuf = (bf16*)(P.ws + WS_X);
      auto epi = [&](f32x16(&acc)[2][2], int row0, int col0) {
        const float* m = mod + (size_t)cond_of(row0) * 6144 + 2 * 1024 + col0;
        wave_tile_epilogue(acc, smem, [&](int row, int c0, const float* rp) {
          float v[8], xv[8], gt[8];
          ld8(rp + c0, v);
          bf16* xp = xbuf + (size_t)(row0 + row) * 1024 + col0 + c0;
          { const u32x4 xw = *(const u32x4*)xp;
#pragma unroll
            for (int e = 0; e < 4; ++e) { xv[2 * e] = bf_lo(xw[e]); xv[2 * e + 1] = bf_hi(xw[e]); } }
          ld8(m + c0, gt);
#pragma unroll
          for (int e = 0; e < 8; ++e) xv[e] = DN_ALPHA * xv[e] + (1.f + gt[e]) * v[e];
          *(u32x4*)xp = pack8(xv);
        });
      };
      const bf16* wt = (layer & 1) == 0 ? (const bf16*)(P.ws + WS_WOUT) + (size_t)j * 1048576 : (const bf16*)(P.ws + WS_AWOUT) + (size_t)j * 1048576;
      gemm_phase(1024, PlainALF{(const bf16*)(P.ws + WS_Z)}, wt, epi, smem);
    } PH_END
    PH_BEGIN(8) ln_phase(P, layer, 0); PH_END
    PH_BEGIN(9) route_phase(P, layer, smem); PH_END
    PH_BEGIN(10)
      gatherU_phase(P, layer, smem);
      asm volatile("s_waitcnt vmcnt(0)" ::: "memory"); __builtin_amdgcn_fence(__ATOMIC_ACQUIRE, "agent"); asm volatile("s_waitcnt vmcnt(0)" ::: "memory");
      __syncthreads();
      gatherV_phase(P, layer, smem);
      asm volatile("s_waitcnt vmcnt(0)" ::: "memory"); __builtin_amdgcn_fence(__ATOMIC_ACQUIRE, "agent"); asm volatile("s_waitcnt vmcnt(0)" ::: "memory");
      ln_phase(P, layer, 1);
    PH_END
  }
}

constexpr int N_PHASES = 2 + 2 * 8 + 2 * 6;

extern "C" void kernel_launch(void* const* d_in, const int* in_sizes, int n_in, void* d_out, int out_size, void* d_ws, size_t ws_size, hipStream_t stream) {
  static int grid_blocks = 0;
  if (!grid_blocks) {
    int dev = 0, cus = 0, per_cu = 0;
    (void)hipGetDevice(&dev);
    (void)hipDeviceGetAttribute(&cus, hipDeviceAttributeMultiprocessorCount, dev);
    (void)hipOccupancyMaxActiveBlocksPerMultiprocessor(&per_cu, fwd_kernel, 256, 0);
    if (per_cu < 1) per_cu = 1;
    if (per_cu > 2) per_cu = 2;
    grid_blocks = cus * per_cu;
    if (ws_size < WS_END) fprintf(stderr, "kernel_launch: workspace too small: %zu < %zu\n", ws_size, (size_t)WS_END);
  }
  Params p;
  memset(&p, 0, sizeof(p));
  const float** fp = (const float**)&p;
  for (int i = 0; i < 30; ++i) fp[i] = (const float*)d_in[i];
  p.out = (float*)d_out;
  p.ws = (char*)d_ws;
  (void)hipMemsetAsync((char*)d_ws + WS_BAR, 0, XCD_BAR_WORDS * sizeof(unsigned), stream);
#if MULTI_LAUNCH
  for (int ph = 0; ph < N_PHASES; ++ph) {
    p.p0 = ph; p.p1 = ph + 1;
    hipLaunchKernelGGL(fwd_kernel, dim3(grid_blocks), dim3(256), 0, stream, p);
  }
#else
  p.p0 = 0; p.p1 = N_PHASES;
  void* args[] = {&p};
  hipError_t e = hipLaunchCooperativeKernel((void*)fwd_kernel, dim3(grid_blocks), dim3(256), args, 0, stream);
  if (e != hipSuccess) fprintf(stderr, "cooperative launch failed: %s (grid %d)\n", hipGetErrorString(e), grid_blocks);
#endif
}
```

```cpp
#include <hip/hip_runtime.h>
#include <hip/hip_cooperative_groups.h>
#include <stdint.h>
#include <stdio.h>
#include <string.h>
namespace cg = cooperative_groups;

#ifndef MULTI_LAUNCH
#define MULTI_LAUNCH 0
#endif

#define DI __device__ __forceinline__
typedef unsigned short bf16;
typedef __attribute__((ext_vector_type(8))) short bf16x8;
typedef __attribute__((ext_vector_type(16))) float f32x16;
typedef __attribute__((ext_vector_type(4))) float f32x4;
typedef __attribute__((ext_vector_type(4))) unsigned u32x4;
typedef __attribute__((ext_vector_type(2))) unsigned u32x2;
typedef __bf16 bf2_t __attribute__((ext_vector_type(2)));
typedef float fl2_t __attribute__((ext_vector_type(2)));

#define MFMA32(a, b, c) __builtin_amdgcn_mfma_f32_32x32x16_bf16((a), (b), (c), 0, 0, 0)

constexpr int D = 1024;
constexpr int NCTX = 8192;
constexpr int NTOK = 40960;
constexpr int DEPTH = 4;
constexpr float DN_ALPHA = 1.681792830507429f;
constexpr float LN_EPS = 1e-5f;

constexpr size_t OUT_Y = 0;
constexpr size_t OUT_SRE = 41943040;
constexpr size_t OUT_SIM = 42467328;
constexpr size_t OUT_CK = 42991616;
constexpr size_t OUT_CV = 47185920;

constexpr size_t MiB = 1048576;
constexpr size_t WS_WIN = 0;
constexpr size_t WS_WGLU = WS_WIN + 4 * MiB;
constexpr size_t WS_WOUT = WS_WGLU + 8 * MiB;
constexpr size_t WS_WQKV = WS_WOUT + 4 * MiB;
constexpr size_t WS_AWOUT = WS_WQKV + 6 * MiB;
constexpr size_t WS_WQ = WS_AWOUT + 4 * MiB;
constexpr size_t WS_KEYS = WS_WQ + 16 * MiB;
constexpr size_t WS_PU = WS_KEYS + 2 * MiB;
constexpr size_t WS_PV = WS_PU + 128 * MiB;
constexpr size_t WS_CK = WS_PV + 128 * MiB;
constexpr size_t WS_CV = WS_CK + 4 * MiB;
constexpr size_t WS_MOD = WS_CV + 4 * MiB;
constexpr size_t WS_ROPE = WS_MOD + 1 * MiB;
constexpr size_t WS_X = WS_ROPE + 1 * MiB;
constexpr size_t WS_H = WS_X + 160 * MiB;
constexpr size_t WS_U = WS_H + 80 * MiB;
constexpr size_t WS_YF = WS_U + 80 * MiB;
constexpr size_t WS_YB = WS_YF + 80 * MiB;
constexpr size_t WS_Z = WS_YB + 80 * MiB;
constexpr size_t WS_IDX = WS_Z + 80 * MiB;
constexpr size_t WS_G = WS_IDX + 20 * MiB;
constexpr size_t WS_BAR = WS_G + 20 * MiB;
constexpr size_t WS_ACT = WS_BAR + 1 * MiB;
constexpr size_t WS_END = WS_ACT + 20 * MiB;

struct Params {
  const float *x_prompt, *x_sample, *st_re, *st_im, *cache_k, *cache_v, *c, *c_ctx, *w_mod, *b_mod, *ln_g, *ln_b;
  const float *ssm_w_in, *ssm_a_re, *ssm_a_im, *ssm_log_dt, *ssm_b_re, *ssm_b_im, *ssm_c_re, *ssm_c_im, *ssm_d, *ssm_w_glu, *ssm_w_out;
  const float *attn_w_qkv, *attn_sink, *attn_w_out, *peer_w_q, *peer_keys, *peer_u, *peer_v;
  float* out;
  char* ws;
  int p0, p1;
};

DI int tidx() { int t = (int)__builtin_amdgcn_workitem_id_x(); asm volatile("" : "+v"(t)); return t; }
DI unsigned pack_bf16(float lo, float hi) { fl2_t f = {lo, hi}; bf2_t b = __builtin_convertvector(f, bf2_t); return __builtin_bit_cast(unsigned, b); }
DI float bf_lo(unsigned w) { return __uint_as_float(w << 16); }
DI float bf_hi(unsigned w) { return __uint_as_float(w & 0xffff0000u); }
DI f32x4 unpack4(u32x2 w) { return f32x4{__uint_as_float(w[0] << 16), __uint_as_float(w[0] & 0xffff0000u), __uint_as_float(w[1] << 16), __uint_as_float(w[1] & 0xffff0000u)}; }
DI float bf1(bf16 v) { return __uint_as_float(((unsigned)v) << 16); }
DI bf16 f2bf(float x) { return (bf16)(pack_bf16(x, 0.f) & 0xffffu); }
DI float gelu_tanh(float x) { float z = 0.7978845608028654f * (x + 0.044715f * x * x * x); return x / (1.f + __expf(-2.f * z)); }
DI float sigmoidf_(float x) { return 1.f / (1.f + __expf(-x)); }
DI int crow(int i, int h) { return (i & 3) + 8 * (i >> 2) + 4 * h; }
DI int cond_of(int tok) { return tok < NCTX ? 0 : 1 + ((tok - NCTX) >> 12); }
DI void wave_fence() { asm volatile("" ::: "memory"); __builtin_amdgcn_wave_barrier(); asm volatile("" ::: "memory"); }
DI float wave_sum(float v) {
#pragma unroll
  for (int o = 32; o > 0; o >>= 1) v += __shfl_xor(v, o);
  return v;
}
DI int imax(int a, int b) { return a > b ? a : b; }
DI int imin(int a, int b) { return a < b ? a : b; }
DI int f2key(float f) { int b = __float_as_int(f); return b ^ ((b >> 31) & 0x7fffffff); }
DI int key2bits(int k) { return k ^ ((k >> 31) & 0x7fffffff); }
DI int bsel(int mask, int a, int b) { return (a & ~mask) | (b & mask); }

DI void cswap(int& a, int& b) { int mx = imax(a, b), mn = imin(a, b); a = mx; b = mn; }
template <int N, int OFF>
DI void sort16_desc(int (&v)[N]) {
#pragma unroll
  for (int k = 2; k <= 16; k <<= 1) {
#pragma unroll
    for (int jj = k >> 1; jj > 0; jj >>= 1) {
#pragma unroll
      for (int i = 0; i < 16; ++i) {
        const int l = i ^ jj;
        if (l > i) {
          if ((i & k) == 0) cswap(v[OFF + i], v[OFF + l]);
          else cswap(v[OFF + l], v[OFF + i]);
        }
      }
    }
  }
}
template <int N, int OA, int OB>
DI void merge16_desc(int (&v)[N]) {
#pragma unroll
  for (int i = 0; i < 16; ++i) v[OA + i] = imax(v[OA + i], v[OB + 15 - i]);
#pragma unroll
  for (int jj = 8; jj > 0; jj >>= 1) {
#pragma unroll
    for (int i = 0; i < 16; ++i) {
      const int l = i ^ jj;
      if (l > i) cswap(v[OA + i], v[OA + l]);
    }
  }
}
template <int N>
DI void pair_merge16(int (&v)[N]) {
  static_assert(N >= 32, "");
#pragma unroll
  for (int i = 0; i < 16; ++i) v[16 + i] = __shfl_xor(v[i], 32);
  merge16_desc<N, 0, 16>(v);
}

constexpr int BK = 64;
constexpr int LROW = 144;
constexpr int TILE_BYTES = 128 * LROW;
constexpr int SMEM_BYTES = 4 * TILE_BYTES;

struct PlainLoad {
  const bf16* base;
  int ld;
  DI u32x4 operator()(int row, int k) const { return *(const u32x4*)(base + (size_t)row * ld + k); }
};

template <int MB, int NB, class AL, class BL>
DI void mainloop(f32x16 (&acc)[MB][NB], const AL& al, const BL& bl, int K, char* smem, int arow0, int brow0) {
  const int tid = tidx(), lane = tid & 63, r31 = lane & 31, hh = lane >> 5;
#pragma unroll
  for (int a = 0; a < MB; ++a)
#pragma unroll
    for (int b = 0; b < NB; ++b)
#pragma unroll
      for (int i = 0; i < 16; ++i) acc[a][b][i] = 0.f;
  u32x4 ra[4], rb[4];
  const int KT = K / BK;
#pragma unroll
  for (int i = 0; i < 4; ++i) { const int c = tid + 256 * i; ra[i] = al(c >> 3, (c & 7) * 8); rb[i] = bl(c >> 3, (c & 7) * 8); }
#pragma unroll
  for (int i = 0; i < 4; ++i) {
    const int c = tid + 256 * i;
    *(u32x4*)(smem + (c >> 3) * LROW + (c & 7) * 16) = ra[i];
    *(u32x4*)(smem + 2 * TILE_BYTES + (c >> 3) * LROW + (c & 7) * 16) = rb[i];
  }
  __syncthreads();
  for (int kt = 0; kt < KT; ++kt) {
    const int buf = kt & 1;
    if (kt + 1 < KT) {
#pragma unroll
      for (int i = 0; i < 4; ++i) { const int c = tid + 256 * i; ra[i] = al(c >> 3, (kt + 1) * BK + (c & 7) * 8); rb[i] = bl(c >> 3, (kt + 1) * BK + (c & 7) * 8); }
    }
    const char* sa = smem + buf * TILE_BYTES + (arow0 + r31) * LROW + hh * 16;
    const char* sb = smem + (2 + buf) * TILE_BYTES + (brow0 + r31) * LROW + hh * 16;
#pragma unroll
    for (int s = 0; s < 4; ++s) {
      bf16x8 af[MB], bfv[NB];
#pragma unroll
      for (int a = 0; a < MB; ++a) af[a] = *(const bf16x8*)(sa + a * 32 * LROW + s * 32);
#pragma unroll
      for (int b = 0; b < NB; ++b) bfv[b] = *(const bf16x8*)(sb + b * 32 * LROW + s * 32);
#pragma unroll
      for (int a = 0; a < MB; ++a)
#pragma unroll
        for (int b = 0; b < NB; ++b) acc[a][b] = MFMA32(af[a], bfv[b], acc[a][b]);
    }
    if (kt + 1 < KT) {
#pragma unroll
      for (int i = 0; i < 4; ++i) {
        const int c = tid + 256 * i;
        *(u32x4*)(smem + (buf ^ 1) * TILE_BYTES + (c >> 3) * LROW + (c & 7) * 16) = ra[i];
        *(u32x4*)(smem + (2 + (buf ^ 1)) * TILE_BYTES + (c >> 3) * LROW + (c & 7) * 16) = rb[i];
      }
    }
    __syncthreads();
  }
}

DI int glu_perm(int n) { return n < 1024 ? ((n >> 5) * 64 + (n & 31)) : (((n - 1024) >> 5) * 64 + 32 + ((n - 1024) & 31)); }

DI void conv_transpose_tile(const float* src, int N, bf16* dst, int tk, int tn, bool perm, char* smem) {
  bf16* T = (bf16*)smem;
  const int tid = tidx();
  __syncthreads();
#pragma unroll
  for (int ps = 0; ps < 4; ++ps) {
    const int r = ps * 16 + (tid >> 4), c4 = (tid & 15) * 4;
    const f32x4 v = *(const f32x4*)(src + (size_t)(tk * 64 + r) * N + tn * 64 + c4);
#pragma unroll
    for (int e = 0; e < 4; ++e) T[(c4 + e) * 66 + r] = f2bf(v[e]);
  }
  __syncthreads();
  const int c = tid >> 2, seg = tid & 3;
  int n = tn * 64 + c;
  if (perm) n = glu_perm(n);
  unsigned w[8];
#pragma unroll
  for (int e = 0; e < 8; ++e) w[e] = (unsigned)T[c * 66 + seg * 16 + 2 * e] | ((unsigned)T[c * 66 + seg * 16 + 2 * e + 1] << 16);
  bf16* d = dst + (size_t)n * 1024 + tk * 64 + seg * 16;
  *(u32x4*)d = u32x4{w[0], w[1], w[2], w[3]};
  *(u32x4*)(d + 8) = u32x4{w[4], w[5], w[6], w[7]};
}

DI void conv_elem(const float* src, bf16* dst, size_t base) {
  const size_t e = base + (size_t)tidx() * 8;
  const f32x4 a = *(const f32x4*)(src + e), b = *(const f32x4*)(src + e + 4);
  *(u32x4*)(dst + e) = u32x4{pack_bf16(a[0], a[1]), pack_bf16(a[2], a[3]), pack_bf16(b[0], b[1]), pack_bf16(b[2], b[3])};
}

constexpr float PEER_SU = 64.f, PEER_SV = 13.f;
DI unsigned enc_fp4(float x, float sc) {
  const float a = fabsf(x * sc);
  const unsigned code = (unsigned)(a >= 0.25f) + (unsigned)(a >= 0.75f) + (unsigned)(a >= 1.25f) + (unsigned)(a >= 1.75f) +
                        (unsigned)(a >= 2.5f) + (unsigned)(a >= 3.5f) + (unsigned)(a >= 5.f);
  return code | (x < 0.f ? 8u : 0u);
}
DI void conv_elem_fp4(const float* src, unsigned char* dst, size_t base, float sc) {
  const size_t e = base + (size_t)tidx() * 32;
  const size_t le = e >> 10, col = e & 1023;
  unsigned dw[4] = {0u, 0u, 0u, 0u};
#pragma unroll
  for (int q4 = 0; q4 < 8; ++q4) {
    const f32x4 v = *(const f32x4*)(src + e + 4 * q4);
#pragma unroll
    for (int t = 0; t < 4; ++t) { const int k = 4 * q4 + t; dw[k >> 3] |= enc_fp4(v[t], sc) << (4 * (k & 7)); }
  }
  unsigned char* p = dst + (((le >> 14) * 4 + (col >> 8)) * 16384 + (le & 16383)) * 128 + ((col & 255) >> 1);
  *(u32x4*)p = u32x4{dw[0], dw[1], dw[2], dw[3]};
}
DI unsigned pack4_fp8(float a, float b, float c, float d, float sc) {
  a = fminf(fmaxf(a * sc, -448.f), 448.f); b = fminf(fmaxf(b * sc, -448.f), 448.f);
  c = fminf(fmaxf(c * sc, -448.f), 448.f); d = fminf(fmaxf(d * sc, -448.f), 448.f);
  int p = 0;
  p = __builtin_amdgcn_cvt_pk_fp8_f32(a, b, p, false);
  p = __builtin_amdgcn_cvt_pk_fp8_f32(c, d, p, true);
  return (unsigned)p;
}
DI void conv_elem_fp8(const float* src, unsigned char* dst, size_t base, float sc) {
  const size_t e = base + (size_t)tidx() * 16;
  const size_t le = e >> 10, col = e & 1023;
  const size_t de = (((le >> 14) * 8 + (col >> 7)) * 16384 + (le & 16383)) * 128 + (col & 127);
  const f32x4 a = *(const f32x4*)(src + e), b = *(const f32x4*)(src + e + 4), c = *(const f32x4*)(src + e + 8), d = *(const f32x4*)(src + e + 12);
  *(u32x4*)(dst + de) = u32x4{pack4_fp8(a[0], a[1], a[2], a[3], sc), pack4_fp8(b[0], b[1], b[2], b[3], sc), pack4_fp8(c[0], c[1], c[2], c[3], sc), pack4_fp8(d[0], d[1], d[2], d[3], sc)};
}

DI void conv_phase(const Params& P, char* smem) {
  const int tid = tidx();
  constexpr int N_MOD = 384, N_TR = 5376, N_EL = 512 + 16384 + 2048;
  for (int item = blockIdx.x; item < N_MOD + N_TR + N_EL + 1; item += gridDim.x) {
    if (item < N_MOD) {
      const int layer = item / 96, cgp = item % 96;
      float* ssilu = (float*)smem;
      float* red = (float*)(smem + 36864);
      __syncthreads();
      for (int o = tid; o < 9 * 1024; o += 256) {
        const int cc = o >> 10, k = o & 1023;
        const float v = cc == 0 ? P.c_ctx[k] : P.c[(cc - 1) * 1024 + k];
        ssilu[o] = v / (1.f + __expf(-v));
      }
      __syncthreads();
      const int kq = tid >> 6, n = tid & 63;
      float acc[9];
#pragma unroll
      for (int cc = 0; cc < 9; ++cc) acc[cc] = 0.f;
      const float* wp = P.w_mod + ((size_t)layer * 1024 + kq * 256) * 6144 + cgp * 64 + n;
#pragma unroll 16
      for (int k = 0; k < 256; ++k) {
        const float w = wp[(size_t)k * 6144];
#pragma unroll
        for (int cc = 0; cc < 9; ++cc) acc[cc] += ssilu[cc * 1024 + kq * 256 + k] * w;
      }
#pragma unroll
      for (int cc = 0; cc < 9; ++cc) red[(kq * 9 + cc) * 64 + n] = acc[cc];
      __syncthreads();
      for (int o = tid; o < 576; o += 256) {
        const int cc = o >> 6, nn = o & 63;
        const float s = red[(0 * 9 + cc) * 64 + nn] + red[(1 * 9 + cc) * 64 + nn] + red[(2 * 9 + cc) * 64 + nn] + red[(3 * 9 + cc) * 64 + nn];
        ((float*)(P.ws + WS_MOD))[((size_t)layer * 9 + cc) * 6144 + cgp * 64 + nn] = s + P.b_mod[layer * 6144 + cgp * 64 + nn];
      }
    } else if (item < N_MOD + N_TR) {
      int t = item - N_MOD;
      const float* src; bf16* dst; int N; bool perm = false;
      if (t < 512) { const int j = t >> 8; t &= 255; src = P.ssm_w_in + (size_t)j * 1048576; dst = (bf16*)(P.ws + WS_WIN) + (size_t)j * 1048576; N = 1024; }
      else if (t < 1536) { t -= 512; const int j = t >> 9; t &= 511; src = P.ssm_w_glu + (size_t)j * 2097152; dst = (bf16*)(P.ws + WS_WGLU) + (size_t)j * 2097152; N = 2048; perm = true; }
      else if (t < 2048) { t -= 1536; const int j = t >> 8; t &= 255; src = P.ssm_w_out + (size_t)j * 1048576; dst = (bf16*)(P.ws + WS_WOUT) + (size_t)j * 1048576; N = 1024; }
      else if (t < 2816) { t -= 2048; const int j = t / 384; t %= 384; src = P.attn_w_qkv + (size_t)j * 1572864; dst = (bf16*)(P.ws + WS_WQKV) + (size_t)j * 1572864; N = 1536; }
      else if (t < 3328) { t -= 2816; const int j = t >> 8; t &= 255; src = P.attn_w_out + (size_t)j * 1048576; dst = (bf16*)(P.ws + WS_AWOUT) + (size_t)j * 1048576; N = 1024; }
      else { t -= 3328; const int j = t >> 9; t &= 511; src = P.peer_w_q + (size_t)j * 2097152; dst = (bf16*)(P.ws + WS_WQ) + (size_t)j * 2097152; N = 2048; }
      const int ntn = N / 64;
      conv_transpose_tile(src, N, dst, t / ntn, t % ntn, perm, smem);
    } else if (item < N_MOD + N_TR + N_EL) {
      int t = item - N_MOD - N_TR;
      if (t < 512) conv_elem(P.peer_keys, (bf16*)(P.ws + WS_KEYS), (size_t)t * 2048);
      else if (t < 512 + 16384) {
        if (gridDim.x >= 512) continue;
        if (t < 512 + 8192) conv_elem_fp4(P.peer_u, (unsigned char*)(P.ws + WS_PU), (size_t)(t - 512) * 8192, PEER_SU);
        else conv_elem_fp4(P.peer_v, (unsigned char*)(P.ws + WS_PV), (size_t)(t - 512 - 8192) * 8192, PEER_SV);
      }
      else if (t < 512 + 16384 + 1024) conv_elem(P.cache_k, (bf16*)(P.ws + WS_CK), (size_t)(t - 512 - 16384) * 2048);
      else conv_elem(P.cache_v, (bf16*)(P.ws + WS_CV), (size_t)(t - 512 - 16384 - 1024) * 2048);
    } else {
      float* rt = (float*)(P.ws + WS_ROPE);
      for (int o = tid; o < 1024; o += 256) {
        const int pos = o >> 4, f = o & 15;
        const float inv = powf(10000.f, -(float)f / 16.f);
        const float ang = (float)pos * inv;
        rt[o] = cosf(ang);
        rt[1024 + o] = sinf(ang);
      }
    }
  }
}

DI void prep_phase(const Params& P) {
  const float* mod = (const float*)(P.ws + WS_MOD);
  bf16* x = (bf16*)(P.ws + WS_X);
  bf16* h = (bf16*)(P.ws + WS_H);
  const size_t nvec = (size_t)NTOK * D / 8;
  for (size_t v = (size_t)blockIdx.x * 256 + tidx(); v < nvec; v += (size_t)gridDim.x * 256) {
    const int tok = (int)(v >> 7), col = (int)(v & 127) * 8;
    const float* src = tok < NCTX ? P.x_prompt + (size_t)tok * D + col : P.x_sample + (size_t)(tok - NCTX) * D + col;
    const f32x4 a = *(const f32x4*)src, b = *(const f32x4*)(src + 4);
    *(u32x4*)(x + (size_t)tok * D + col) = u32x4{pack_bf16(a[0], a[1]), pack_bf16(a[2], a[3]), pack_bf16(b[0], b[1]), pack_bf16(b[2], b[3])};
    const float* m = mod + (size_t)cond_of(tok) * 6144;
    const f32x4 sh0 = *(const f32x4*)(m + col), sh1 = *(const f32x4*)(m + col + 4);
    const f32x4 sc0 = *(const f32x4*)(m + 1024 + col), sc1 = *(const f32x4*)(m + 1024 + col + 4);
    float r[8];
#pragma unroll
    for (int e = 0; e < 4; ++e) { r[e] = a[e] * (1.f + sc0[e]) + sh0[e]; r[4 + e] = b[e] * (1.f + sc1[e]) + sh1[e]; }
    *(u32x4*)(h + (size_t)tok * D + col) = u32x4{pack_bf16(r[0], r[1]), pack_bf16(r[2], r[3]), pack_bf16(r[4], r[5]), pack_bf16(r[6], r[7])};
  }
}

template <class ALF, class EPI>
DI void gemm_phase(int N, const ALF& alf, const bf16* Bt, const EPI& epi, char* smem) {
  const int wv = tidx() >> 6;
  const int wm = wv >> 1, wn = wv & 1;
  const int ntn = N / 128;
  const int xcd = blockIdx.x & 7, lb = blockIdx.x >> 3, nlb = (gridDim.x + 7 - xcd) >> 3;
  const int ntx = ((NTOK / 128) - xcd + 7) >> 3;
  for (int t = lb; t < ntx * ntn; t += nlb) {
    const int tm = xcd + 8 * (t / ntn), tn = t % ntn;
    f32x16 acc[2][2];
    auto al = alf(tm * 128);
    PlainLoad bl{Bt + (size_t)tn * 128 * 1024, 1024};
    mainloop<2, 2>(acc, al, bl, 1024, smem, wm * 64, wn * 64);
    epi(acc, tm * 128 + wm * 64, tn * 128 + wn * 64);
    __syncthreads();
  }
}

struct PlainALF {
  const bf16* A;
  DI PlainLoad operator()(int m0) const { return PlainLoad{A + (size_t)m0 * 1024, 1024}; }
};

struct CombLoad {
  const bf16 *yf, *yb, *u;
  const float* d;
  DI u32x4 operator()(int row, int k) const {
    const size_t o = (size_t)row * 1024 + k;
    const u32x4 a = *(const u32x4*)(yf + o), b = *(const u32x4*)(yb + o), c = *(const u32x4*)(u + o);
    const f32x4 d0 = *(const f32x4*)(d + k), d1 = *(const f32x4*)(d + k + 4);
    unsigned r[4];
#pragma unroll
    for (int e = 0; e < 4; ++e) {
      const float dl = e < 2 ? d0[2 * e] : d1[2 * e - 4], dh = e < 2 ? d0[2 * e + 1] : d1[2 * e - 3];
      const float lo = bf_lo(a[e]) + bf_lo(b[e]) + dl * bf_lo(c[e]);
      const float hi = bf_hi(a[e]) + bf_hi(b[e]) + dh * bf_hi(c[e]);
      r[e] = pack_bf16(gelu_tanh(lo), gelu_tanh(hi));
    }
    return u32x4{r[0], r[1], r[2], r[3]};
  }
};
struct CombALF {
  const bf16 *yf, *yb, *u;
  const float* d;
  DI CombLoad operator()(int m0) const { const size_t o = (size_t)m0 * 1024; return CombLoad{yf + o, yb + o, u + o, d}; }
};

DI void comb_phase(const Params& P, int j) {
  bf16* yf = (bf16*)(P.ws + WS_YF);
  const bf16* yb = (const bf16*)(P.ws + WS_YB);
  const bf16* u = (const bf16*)(P.ws + WS_U);
  const float* d = P.ssm_d + (size_t)j * 1024;
  const size_t nvec = (size_t)NTOK * D / 8;
  for (size_t v = (size_t)blockIdx.x * 256 + tidx(); v < nvec; v += (size_t)gridDim.x * 256) {
    const int k = (int)(v & 127) * 8;
    const u32x4 a = *(const u32x4*)(yf + v * 8), b = *(const u32x4*)(yb + v * 8), c = *(const u32x4*)(u + v * 8);
    const f32x4 d0 = *(const f32x4*)(d + k), d1 = *(const f32x4*)(d + k + 4);
    unsigned r[4];
#pragma unroll
    for (int e = 0; e < 4; ++e) {
      const float dl = e < 2 ? d0[2 * e] : d1[2 * e - 4], dh = e < 2 ? d0[2 * e + 1] : d1[2 * e - 3];
      const float lo = bf_lo(a[e]) + bf_lo(b[e]) + dl * bf_lo(c[e]);
      const float hi = bf_hi(a[e]) + bf_hi(b[e]) + dh * bf_hi(c[e]);
      r[e] = pack_bf16(gelu_tanh(lo), gelu_tanh(hi));
    }
    *(u32x4*)(yf + v * 8) = u32x4{r[0], r[1], r[2], r[3]};
  }
}

template <int DIR>
DI void scan_chunks(const bf16* ubuf, bf16* ybuf, float* bu, char* Hs, const bf16x8 (&bfrag)[4], const bf16x8 (&cfrag)[8],
                    float abr, float abi, float& hre, float& him, int tok0, int nchunks, int g) {
  const int lane = tidx() & 63, r31 = lane & 31, hh = lane >> 5;
  f32x16 zero;
#pragma unroll
  for (int i = 0; i < 16; ++i) zero[i] = 0.f;
  bf16x8 ua_next = *(const bf16x8*)(ubuf + (size_t)(tok0 + (DIR ? nchunks - 1 : 0) * 32 + r31) * 1024 + g * 16 + 8 * hh);
  for (int ci = 0; ci < nchunks; ++ci) {
    const int cidx = DIR ? nchunks - 1 - ci : ci;
    const int t0 = tok0 + cidx * 32;
    const bf16x8 ua = ua_next;
    if (ci + 1 < nchunks) {
      const int cn = DIR ? nchunks - 2 - ci : ci + 1;
      ua_next = *(const bf16x8*)(ubuf + (size_t)(tok0 + cn * 32 + r31) * 1024 + g * 16 + 8 * hh);
    }
    f32x16 acc[4];
#pragma unroll
    for (int blk = 0; blk < 4; ++blk) acc[blk] = MFMA32(ua, bfrag[blk], zero);
#pragma unroll
    for (int hf2 = 0; hf2 < 2; ++hf2) {
      constexpr int dsel = DIR;
      const int hf = dsel ? 1 - hf2 : hf2;
#pragma unroll
      for (int blk = 0; blk < 4; ++blk)
#pragma unroll
        for (int i = 0; i < 8; ++i) bu[crow(i, hh) * 128 + 32 * blk + r31] = acc[blk][8 * hf + i];
      wave_fence();
      fl2_t bvs[16];
#pragma unroll
      for (int s = 0; s < 16; ++s) bvs[s] = *(const fl2_t*)(bu + (DIR ? 15 - s : s) * 128 + 2 * lane);
      asm volatile("" ::: "memory");
#pragma unroll
      for (int s = 0; s < 16; ++s) {
        const int tl = DIR ? 15 - s : s;
        const fl2_t bv = bvs[s];
        float nre = __builtin_fmaf(abr, hre, __builtin_fmaf(-abi, him, bv[0]));
        asm volatile("" : "+v"(nre));
        float nim = __builtin_fmaf(abr, him, __builtin_fmaf(abi, hre, bv[1]));
        asm volatile("" : "+v"(nim));
        hre = nre; him = nim;
        *(unsigned*)(Hs + (hf * 16 + tl) * 272 + lane * 4) = pack_bf16(hre, him);
      }
      wave_fence();
    }
    f32x16 y = zero, y2 = zero;
#pragma unroll
    for (int s = 0; s < 8; s += 2) {
      const bf16x8 a = *(const bf16x8*)(Hs + r31 * 272 + s * 32 + hh * 16);
      const bf16x8 a2 = *(const bf16x8*)(Hs + r31 * 272 + (s + 1) * 32 + hh * 16);
      y = MFMA32(a, cfrag[s], y);
      y2 = MFMA32(a2, cfrag[s + 1], y2);
    }
    wave_fence();
    bf16* ys = (bf16*)bu;
    if (r31 < 16) {
#pragma unroll
      for (int i = 0; i < 16; ++i) ys[crow(i, hh) * 16 + r31] = f2bf(y[i] + y2[i]);
    }
    wave_fence();
    {
      const u32x4 w = *(const u32x4*)(ys + (lane >> 1) * 16 + (lane & 1) * 8);
      *(u32x4*)(ybuf + (size_t)(t0 + (lane >> 1)) * 1024 + g * 16 + (lane & 1) * 8) = w;
    }
    wave_fence();
  }
}

DI void scan_phase(const Params& P, int j, char* smem) {
  const int lane = tidx() & 63, wv = tidx() >> 6, r31 = lane & 31, hh = lane >> 5;

  float* bu = (float*)(smem + wv * 16896);
  char* Hs = smem + wv * 16896 + 8192;
  const bf16* ubuf = (const bf16*)(P.ws + WS_U);
  f32x16 zero;
#pragma unroll
  for (int i = 0; i < 16; ++i) zero[i] = 0.f;
  const bool split = gridDim.x >= 320;
  const int it0 = split ? (blockIdx.x < 256 ? (int)blockIdx.x : 256 + ((int)blockIdx.x - 256)) : (int)blockIdx.x;
  const int itstep = split ? (blockIdx.x < 256 ? 1 << 20 : (int)gridDim.x - 256) : (int)gridDim.x;
  for (int item = it0; item < 1280; item += itstep) {
    const bool lat = item < 256;
    const int cc = lat ? item : item - 256;
    const int dir = cc & 1, g = ((cc >> 1) & 15) * 4 + wv, b = cc >> 5;
    const int L = lat ? 4096 : 256;
    const int tok0 = lat ? NCTX + b * 4096 : b * 256;
    const int pidx = (j * 2 + dir) * 64 + g;
    const float dt = __expf(P.ssm_log_dt[pidx]);
    float abr, abi;
    {
      const float are = P.ssm_a_re[pidx * 64 + lane], aim = P.ssm_a_im[pidx * 64 + lane];
      const float mag = __expf(are * dt);
      float sn, cs;
      sincosf(aim * dt, &sn, &cs);
      abr = mag * cs; abi = mag * sn;
    }
    bf16x8 bfrag[4];
#pragma unroll
    for (int blk = 0; blk < 4; ++blk) {
      const int n = 32 * blk + r31, p = n >> 1, part = n & 1;
      const float are = P.ssm_a_re[pidx * 64 + p], aim = P.ssm_a_im[pidx * 64 + p];
      const float mag = __expf(are * dt);
      float sn, cs;
      sincosf(aim * dt, &sn, &cs);
      const float xr = mag * cs - 1.f, xi = mag * sn;
      const float den = 1.f / (are * are + aim * aim);
      const float cr = (xr * are + xi * aim) * den, ci = (xi * are - xr * aim) * den;
      const float* br = P.ssm_b_re + ((size_t)pidx * 64 + p) * 16 + 8 * hh;
      const float* bi = P.ssm_b_im + ((size_t)pidx * 64 + p) * 16 + 8 * hh;
      unsigned w[4];
#pragma unroll
      for (int e = 0; e < 4; ++e) {
        const float r0 = br[2 * e], i0 = bi[2 * e], r1 = br[2 * e + 1], i1 = bi[2 * e + 1];
        const float v0 = part ? (cr * i0 + ci * r0) : (cr * r0 - ci * i0);
        const float v1 = part ? (cr * i1 + ci * r1) : (cr * r1 - ci * i1);
        w[e] = pack_bf16(v0, v1);
      }
      bfrag[blk] = __builtin_bit_cast(bf16x8, u32x4{w[0], w[1], w[2], w[3]});
    }
    bf16x8 cfrag[8];
#pragma unroll
    for (int s = 0; s < 8; ++s) {
      unsigned w[4];
#pragma unroll
      for (int e = 0; e < 4; ++e) {
        const int p = 8 * s + 4 * hh + e;
        float v0 = 0.f, v1 = 0.f;
        if (r31 < 16) {
          v0 = P.ssm_c_re[((size_t)pidx * 16 + r31) * 64 + p];
          v1 = -P.ssm_c_im[((size_t)pidx * 16 + r31) * 64 + p];
        }
        w[e] = pack_bf16(v0, v1);
      }
      cfrag[s] = __builtin_bit_cast(bf16x8, u32x4{w[0], w[1], w[2], w[3]});
    }
    float hre = 0.f, him = 0.f;
    if (lat) {
      const size_t si = ((((size_t)b * 2 + j) * 2 + dir) * 64 + g) * 64 + lane;
      hre = P.st_re[si]; him = P.st_im[si];
    }
    bf16* ybuf = (bf16*)(P.ws + (dir ? WS_YB : WS_YF));
    const int nchunks = L / 32;
    if (dir) scan_chunks<1>(ubuf, ybuf, bu, Hs, bfrag, cfrag, abr, abi, hre, him, tok0, nchunks, g);
    else scan_chunks<0>(ubuf, ybuf, bu, Hs, bfrag, cfrag, abr, abi, hre, him, tok0, nchunks, g);
    if (!lat) {
      const size_t so = ((((size_t)b * 2 + j) * 2 + dir) * 64 + g) * 64 + lane;
      P.out[OUT_SRE + so] = hre;
      P.out[OUT_SIM + so] = him;
    }
  }
  if (gridDim.x >= 512 && blockIdx.x >= 256) {
    for (int tt = (int)blockIdx.x - 256; tt < 8192; tt += (int)gridDim.x - 256) {
      const int t = j * 4096 + (tt & 4095);
      if (tt < 4096) conv_elem_fp4(P.peer_u, (unsigned char*)(P.ws + WS_PU), (size_t)t * 8192, PEER_SU);
      else conv_elem_fp4(P.peer_v, (unsigned char*)(P.ws + WS_PV), (size_t)t * 8192, PEER_SV);
    }
  }
}

DI void attn_phase(const Params& P, int j, char* smem) {
  const int tid = tidx(), lane = tid & 63, wv = tid >> 6, r31 = lane & 31, hh = lane >> 5;
  char* Ks = smem;
  char* Vt = smem + 9216;
  const bf16* qbuf = (const bf16*)(P.ws + WS_U);
  const bf16* kbuf = (const bf16*)(P.ws + WS_YF);
  const bf16* vbuf = (const bf16*)(P.ws + WS_YB);
  const bf16* ck = (const bf16*)(P.ws + WS_CK);
  const bf16* cv = (const bf16*)(P.ws + WS_CV);
  bf16* zbuf = (bf16*)(P.ws + WS_Z);
  for (int item = blockIdx.x; item < 5120; item += gridDim.x) {
    const bool lat = item < 4096;
    int qb, head, b, tokq0;
    if (lat) { qb = item & 31; head = (item >> 5) & 15; b = item >> 9; tokq0 = NCTX + b * 4096 + qb * 128; }
    else { const int it = item - 4096; qb = it & 1; head = (it >> 1) & 15; b = it >> 5; tokq0 = b * 256 + qb * 128; }
    const int kvh = head >> 2;
    const int qtok = tokq0 + wv * 32 + r31;
    constexpr float QSC = 0.125f * 1.4426950408889634f;
    bf16x8 qf[4];
#pragma unroll
    for (int s = 0; s < 4; ++s) {
      const u32x4 qr = *(const u32x4*)(qbuf + (size_t)qtok * 1024 + head * 64 + 16 * s + 8 * hh);
      qf[s] = __builtin_bit_cast(bf16x8, u32x4{pack_bf16(bf_lo(qr[0]) * QSC, bf_hi(qr[0]) * QSC), pack_bf16(bf_lo(qr[1]) * QSC, bf_hi(qr[1]) * QSC),
                                                 pack_bf16(bf_lo(qr[2]) * QSC, bf_hi(qr[2]) * QSC), pack_bf16(bf_lo(qr[3]) * QSC, bf_hi(qr[3]) * QSC)});
    }
    float m = P.attn_sink[j * 16 + head] * 1.4426950408889634f;
    float lsum = hh == 0 ? 1.f : 0.f;
    f32x16 o[2];
#pragma unroll
    for (int i = 0; i < 16; ++i) { o[0][i] = 0.f; o[1][i] = 0.f; }
    int t_lo = 0, t_hi = 4;
    if (lat) {
      const int w0 = qb * 128 - 128;
      const int first = w0 < 0 ? 10 : 8;
      int last = 14;
      while (w0 + (last - 1 - 8) * 64 >= 4096) --last;
      t_lo = 0; t_hi = last;
      (void)first;
    }
    auto tile_info = [&](int tile, const bf16*& kb, const bf16*& vb, bool& masked, int& kpos0) -> bool {
      masked = false; kpos0 = 0;
      if (lat) {
        if (tile < 8) {
          const size_t off = (((size_t)b * 2 + j) * 512 + tile * 64) * 256 + kvh * 64;
          kb = ck + off; vb = cv + off;
        } else {
          kpos0 = qb * 128 - 128 + (tile - 8) * 64;
          if (kpos0 < 0 || kpos0 >= 4096) return false;
          masked = true;
          const size_t off = ((size_t)NCTX + b * 4096 + kpos0) * 256 + kvh * 64;
          kb = kbuf + off; vb = vbuf + off;
        }
      } else {
        const size_t off = ((size_t)b * 256 + tile * 64) * 256 + kvh * 64;
        kb = kbuf + off; vb = vbuf + off;
      }
      return true;
    };
    u32x4 pk[2], pv[2];
    auto prefetch = [&](int tile) {
      const bf16 *kb, *vb; bool mk; int kp;
      if (tile < t_hi && tile_info(tile, kb, vb, mk, kp)) {
#pragma unroll
        for (int i = 0; i < 2; ++i) {
          const int c = tid + 256 * i, key = c >> 3, dc = c & 7;
          pk[i] = *(const u32x4*)(kb + (size_t)key * 256 + dc * 8);
          pv[i] = *(const u32x4*)(vb + (size_t)key * 256 + dc * 8);
        }
      }
    };
    prefetch(t_lo);
    for (int tile = t_lo; tile < t_hi; ++tile) {
      const bf16 *kb, *vb;
      bool masked;
      int kpos0;
      if (!tile_info(tile, kb, vb, masked, kpos0)) { prefetch(tile + 1); continue; }
      __syncthreads();
#pragma unroll
      for (int i = 0; i < 2; ++i) {
        const int c = tid + 256 * i, key = c >> 3, dc = c & 7;
        const u32x4 kk = pk[i], vv = pv[i];
        *(u32x4*)(Ks + key * 144 + dc * 16) = kk;
#pragma unroll
        for (int e = 0; e < 4; ++e) {
          *(bf16*)(Vt + (dc * 8 + 2 * e) * 144 + key * 2) = (bf16)(vv[e] & 0xffffu);
          *(bf16*)(Vt + (dc * 8 + 2 * e + 1) * 144 + key * 2) = (bf16)(vv[e] >> 16);
        }
      }
      __syncthreads();
      prefetch(tile + 1);
      f32x16 sacc[2];
#pragma unroll
      for (int i = 0; i < 16; ++i) { sacc[0][i] = 0.f; sacc[1][i] = 0.f; }
#pragma unroll
      for (int mb = 0; mb < 2; ++mb)
#pragma unroll
        for (int s = 0; s < 4; ++s) {
          const bf16x8 a = *(const bf16x8*)(Ks + (mb * 32 + r31) * 144 + s * 32 + hh * 16);
          sacc[mb] = MFMA32(a, qf[s], sacc[mb]);
        }
      float mx = m;
      const int qp = qb * 128 + wv * 32 + r31;
#pragma unroll
      for (int mb = 0; mb < 2; ++mb)
#pragma unroll
        for (int i = 0; i < 16; ++i) {
          float v = sacc[mb][i];
          if (masked) {
            const int dlt = kpos0 + mb * 32 + crow(i, hh) - qp;
            v = (dlt >= -128 && dlt <= 128) ? v : -1e30f;
          }
          sacc[mb][i] = v;
          mx = fmaxf(mx, v);
        }
      mx = fmaxf(mx, __shfl_xor(mx, 32));
      const float alpha = __builtin_amdgcn_exp2f(m - mx);
      if (__builtin_amdgcn_ballot_w64(mx != m) != 0) {
        lsum *= alpha;
#pragma unroll
        for (int i = 0; i < 16; ++i) { o[0][i] *= alpha; o[1][i] *= alpha; }
      }
      m = mx;
#pragma unroll
      for (int mb = 0; mb < 2; ++mb)
#pragma unroll
        for (int i = 0; i < 16; ++i) { const float p = __builtin_amdgcn_exp2f(sacc[mb][i] - mx); sacc[mb][i] = p; lsum += p; }
#pragma unroll
      for (int mb = 0; mb < 2; ++mb)
#pragma unroll
        for (int s2 = 0; s2 < 2; ++s2) {
          const u32x4 pw = u32x4{pack_bf16(sacc[mb][8 * s2 + 0], sacc[mb][8 * s2 + 1]), pack_bf16(sacc[mb][8 * s2 + 2], sacc[mb][8 * s2 + 3]),
                                 pack_bf16(sacc[mb][8 * s2 + 4], sacc[mb][8 * s2 + 5]), pack_bf16(sacc[mb][8 * s2 + 6], sacc[mb][8 * s2 + 7])};
          const bf16x8 pf = __builtin_bit_cast(bf16x8, pw);
#pragma unroll
          for (int db = 0; db < 2; ++db) {
            const char* vp = Vt + (db * 32 + r31) * 144 + (mb * 32 + 16 * s2 + 4 * hh) * 2;
            const u32x2 lo = *(const u32x2*)vp, hi = *(const u32x2*)(vp + 16);
            const bf16x8 a = __builtin_bit_cast(bf16x8, u32x4{lo[0], lo[1], hi[0], hi[1]});
            o[db] = MFMA32(a, pf, o[db]);
          }
        }
    }
    const float ltot = lsum + __shfl_xor(lsum, 32);
    const float inv = 1.f / ltot;
#pragma unroll
    for (int db = 0; db < 2; ++db)
#pragma unroll
      for (int g4 = 0; g4 < 4; ++g4) {
        const u32x2 w = u32x2{pack_bf16(o[db][4 * g4] * inv, o[db][4 * g4 + 1] * inv), pack_bf16(o[db][4 * g4 + 2] * inv, o[db][4 * g4 + 3] * inv)};
        *(u32x2*)(zbuf + (size_t)qtok * 1024 + head * 64 + db * 32 + 8 * g4 + 4 * hh) = w;
      }
  }
}

DI void ln_phase(const Params& P, int layer, int which) {
  const int lane = tidx() & 63, wv = tidx() >> 6;
  const bool last = which == 1 && layer == DEPTH - 1;
  const float* mod = (const float*)(P.ws + WS_MOD) + (size_t)(layer + which) * 9 * 6144 + (which ? 0 : 3 * 1024);
  bf16* x = (bf16*)(P.ws + WS_X);
  bf16* h = (bf16*)(P.ws + WS_H);
  const float* lg = P.ln_g + (size_t)(layer * 2 + which) * 1024;
  const float* lb = P.ln_b + (size_t)(layer * 2 + which) * 1024;
  const int tstride = gridDim.x * 4;
  u32x2 nx[4];
  {
    const int t0 = blockIdx.x * 4 + wv;
    if (t0 < NTOK) {
#pragma unroll
      for (int c = 0; c < 4; ++c) nx[c] = *(const u32x2*)(x + (size_t)t0 * D + c * 256 + lane * 4);
    }
  }
  for (int tok = blockIdx.x * 4 + wv; tok < NTOK; tok += tstride) {
    bf16* xr = x + (size_t)tok * D;
    float v[16];
#pragma unroll
    for (int c = 0; c < 4; ++c) { const f32x4 t = unpack4(nx[c]); v[4 * c] = t[0]; v[4 * c + 1] = t[1]; v[4 * c + 2] = t[2]; v[4 * c + 3] = t[3]; }
    if (tok + tstride < NTOK) {
#pragma unroll
      for (int c = 0; c < 4; ++c) nx[c] = *(const u32x2*)(x + (size_t)(tok + tstride) * D + c * 256 + lane * 4);
    }
    float s = 0.f;
#pragma unroll
    for (int e = 0; e < 16; ++e) s += v[e];
    const float mu = wave_sum(s) * (1.f / 1024.f);
    float q = 0.f;
#pragma unroll
    for (int e = 0; e < 16; ++e) { const float d = v[e] - mu; q += d * d; }
    const float rstd = rsqrtf(wave_sum(q) * (1.f / 1024.f) + LN_EPS);
    const float* m = mod + (size_t)cond_of(tok) * 6144;
#pragma unroll
    for (int c = 0; c < 4; ++c) {
      const int col = c * 256 + lane * 4;
      const f32x4 g4 = *(const f32x4*)(lg + col), b4 = *(const f32x4*)(lb + col);
      f32x4 y;
#pragma unroll
      for (int e = 0; e < 4; ++e) y[e] = (v[4 * c + e] - mu) * rstd * g4[e] + b4[e];
      if (last) { *(f32x4*)(P.out + OUT_Y + (size_t)tok * D + col) = y; continue; }
      const f32x4 sh = *(const f32x4*)(m + col), sc = *(const f32x4*)(m + 1024 + col);
      float hv[4];
#pragma unroll
      for (int e = 0; e < 4; ++e) hv[e] = y[e] * (1.f + sc[e]) + sh[e];
      *(u32x2*)(xr + col) = u32x2{pack_bf16(y[0], y[1]), pack_bf16(y[2], y[3])};
      *(u32x2*)(h + (size_t)tok * D + col) = u32x2{pack_bf16(hv[0], hv[1]), pack_bf16(hv[2], hv[3])};
    }
  }
}

DI void route_phase(const Params& P, int layer, char* smem) {
  const int tid = tidx(), lane = tid & 63, wv = tid >> 6, r31 = lane & 31, hh = lane >> 5;
  const bf16* hbuf = (const bf16*)(P.ws + WS_H);
  const bf16* wq = (const bf16*)(P.ws + WS_WQ) + (size_t)layer * 2097152;
  const bf16* keys = (const bf16*)(P.ws + WS_KEYS);
  int* idxo = (int*)(P.ws + WS_IDX);
  float* go = (float*)(P.ws + WS_G);
  f32x16 zero;
#pragma unroll
  for (int i = 0; i < 16; ++i) zero[i] = 0.f;
  const int xcd = blockIdx.x & 7, lb = blockIdx.x >> 3, nlb = (gridDim.x + 7 - xcd) >> 3;
  const int ntx = (320 - xcd + 7) >> 3;
  for (int item = lb; item < ntx * 8; item += nlb) {
    const int tm = xcd + 8 * (item >> 3), head = item & 7;
    const int hmask = -hh;
    int t1[16], t2[16];
    for (int half = 0; half < 2; ++half) {
      f32x16 acc[4][1];
      PlainLoad al{wq + ((size_t)head * 256 + half * 128) * 1024, 1024};
      PlainLoad bl{hbuf + (size_t)tm * 128 * 1024, 1024};
      const bf16* kbase = keys + ((((size_t)layer * 2 + half) * 8 + head) * 128) * 128;
      u32x4 kreg[8];
#pragma unroll
      for (int i = 0; i < 8; ++i) { const int c = tid + 256 * i; kreg[i] = *(const u32x4*)(kbase + (size_t)(c >> 4) * 128 + (c & 15) * 8); }
      mainloop<4, 1>(acc, al, bl, 1024, smem, 0, wv * 32);
#pragma unroll
      for (int i = 0; i < 8; ++i) { const int c = tid + 256 * i; *(u32x4*)(smem + (c >> 4) * 272 + (c & 15) * 16) = kreg[i]; }
      __syncthreads();
      bf16x8 qf[4][2];
#pragma unroll
      for (int mb = 0; mb < 4; ++mb)
#pragma unroll
        for (int s2 = 0; s2 < 2; ++s2) {
          const f32x16& a = acc[mb][0];
          qf[mb][s2] = __builtin_bit_cast(bf16x8, u32x4{pack_bf16(a[8 * s2 + 0], a[8 * s2 + 1]), pack_bf16(a[8 * s2 + 2], a[8 * s2 + 3]),
                                                         pack_bf16(a[8 * s2 + 4], a[8 * s2 + 5]), pack_bf16(a[8 * s2 + 6], a[8 * s2 + 7])});
        }
      int v[64];
#pragma unroll
      for (int kb = 0; kb < 4; ++kb) {
        f32x16 sc = zero;
#pragma unroll
        for (int mb = 0; mb < 4; ++mb)
#pragma unroll
          for (int s2 = 0; s2 < 2; ++s2) {
            const char* kp = smem + (kb * 32 + r31) * 272 + (mb * 32 + 16 * s2 + 4 * hh) * 2;
            const u32x2 lo = *(const u32x2*)kp, hi = *(const u32x2*)(kp + 16);
            const bf16x8 a = __builtin_bit_cast(bf16x8, u32x4{lo[0], lo[1], hi[0], hi[1]});
            sc = MFMA32(a, qf[mb][s2], sc);
          }
#pragma unroll
        for (int i = 0; i < 16; ++i) {
          const int key = kb * 32 + crow(i, hh);
          v[kb * 16 + i] = f2key(__int_as_float((__float_as_int(sc[i]) & ~0x7f) | key));
        }
      }
      __syncthreads();
      sort16_desc<64, 0>(v); sort16_desc<64, 16>(v); sort16_desc<64, 32>(v); sort16_desc<64, 48>(v);
      merge16_desc<64, 0, 16>(v); merge16_desc<64, 32, 48>(v); merge16_desc<64, 0, 32>(v);
      pair_merge16<64>(v);
      if (half == 0) {
#pragma unroll
        for (int i = 0; i < 16; ++i) t1[i] = key2bits(v[i]);
      } else {
#pragma unroll
        for (int i = 0; i < 16; ++i) t2[i] = key2bits(v[i]);
      }
    }
    int cd[32];
    {
      int ce[25], co[25];
      int cnt = 0;
#pragma unroll
      for (int a = 0; a < 16; ++a)
#pragma unroll
        for (int bq = 0; bq < 16; ++bq) {
          if ((a + 1) * (bq + 1) <= 16) {
            const float sum = __int_as_float(t1[a] & ~0x7f) + __int_as_float(t2[bq] & ~0x7f);
            const int kk = f2key(__int_as_float((__float_as_int(sum) & ~0xff) | (a * 16 + bq)));
            if ((cnt & 1) == 0) ce[cnt >> 1] = kk; else co[cnt >> 1] = kk;
            ++cnt;
          }
        }
#pragma unroll
      for (int s = 0; s < 25; ++s) cd[s] = bsel(hmask, ce[s], co[s]);
#pragma unroll
      for (int s = 25; s < 32; ++s) cd[s] = (int)0x80000000;
    }
    sort16_desc<32, 0>(cd); sort16_desc<32, 16>(cd);
    merge16_desc<32, 0, 16>(cd);
    pair_merge16<32>(cd);
    unsigned char* tab = (unsigned char*)smem + wv * 1024;
    {
      unsigned w[4];
#pragma unroll
      for (int e = 0; e < 4; ++e) {
        const unsigned b0 = (unsigned)(bsel(hmask, t1[4 * e], t2[4 * e]) & 0x7f), b1 = (unsigned)(bsel(hmask, t1[4 * e + 1], t2[4 * e + 1]) & 0x7f);
        const unsigned b2 = (unsigned)(bsel(hmask, t1[4 * e + 2], t2[4 * e + 2]) & 0x7f), b3 = (unsigned)(bsel(hmask, t1[4 * e + 3], t2[4 * e + 3]) & 0x7f);
        w[e] = b0 | (b1 << 8) | (b2 << 16) | (b3 << 24);
      }
      *(u32x4*)(tab + r31 * 32 + hh * 16) = u32x4{w[0], w[1], w[2], w[3]};
    }
    wave_fence();
    float vals[16]; int eidx[16];
    float ssum = 0.f;
    const float v0 = __int_as_float(key2bits(cd[0]) & ~0xff);
#pragma unroll
    for (int r = 0; r < 16; ++r) {
      const int bits = key2bits(cd[r]);
      const int code = bits & 0xff;
      const int i1 = tab[r31 * 32 + (code >> 4)], i2 = tab[r31 * 32 + 16 + (code & 15)];
      eidx[r] = i1 * 128 + i2;
      vals[r] = __expf(__int_as_float(bits & ~0xff) - v0);
      ssum += vals[r];
    }
    const float inv = 1.f / ssum;
    const int tok = tm * 128 + wv * 32 + r31;
    int ei[8]; float gv[8];
#pragma unroll
    for (int r = 0; r < 8; ++r) { ei[r] = bsel(hmask, eidx[r], eidx[8 + r]); gv[r] = __int_as_float(bsel(hmask, __float_as_int(vals[r]), __float_as_int(vals[8 + r]))) * inv; }
    const size_t ob = ((size_t)tok * 8 + head) * 16 + 8 * hh;
    *(u32x4*)(idxo + ob) = u32x4{(unsigned)ei[0], (unsigned)ei[1], (unsigned)ei[2], (unsigned)ei[3]};
    *(u32x4*)(idxo + ob + 4) = u32x4{(unsigned)ei[4], (unsigned)ei[5], (unsigned)ei[6], (unsigned)ei[7]};
    *(f32x4*)(go + ob) = f32x4{gv[0], gv[1], gv[2], gv[3]};
    *(f32x4*)(go + ob + 4) = f32x4{gv[4], gv[5], gv[6], gv[7]};
    __syncthreads();
  }
}

DI float dpp_f(float x, const int ctrl_sel) {
  const int xi = __float_as_int(x);
  int r;
  if (ctrl_sel == 0) r = __builtin_amdgcn_update_dpp(0, xi, 0xB1, 0xf, 0xf, false);
  else if (ctrl_sel == 1) r = __builtin_amdgcn_update_dpp(0, xi, 0x4E, 0xf, 0xf, false);
  else if (ctrl_sel == 2) r = __builtin_amdgcn_update_dpp(0, xi, 0x141, 0xf, 0xf, false);
  else r = __builtin_amdgcn_update_dpp(0, xi, 0x140, 0xf, 0xf, false);
  return __int_as_float(r);
}
DI float row16_sum(float s) { s += dpp_f(s, 0); s += dpp_f(s, 1); s += dpp_f(s, 2); s += dpp_f(s, 3); return s; }

DI float row8_sum(float s) { s += dpp_f(s, 0); s += dpp_f(s, 1); s += dpp_f(s, 2); return s; }
DI float ror8_add(float x) { return x + __int_as_float(__builtin_amdgcn_update_dpp(0, __float_as_int(x), 0x128, 0xf, 0xf, false)); }

DI fl2_t dec4(unsigned w, int b) {
  if (b == 0) return __builtin_amdgcn_cvt_scalef32_pk_f32_fp4(w, 1.0f, 0);
  if (b == 1) return __builtin_amdgcn_cvt_scalef32_pk_f32_fp4(w, 1.0f, 1);
  if (b == 2) return __builtin_amdgcn_cvt_scalef32_pk_f32_fp4(w, 1.0f, 2);
  return __builtin_amdgcn_cvt_scalef32_pk_f32_fp4(w, 1.0f, 3);
}
constexpr float PEER_HS = 2.f;
typedef __attribute__((ext_vector_type(8))) int i32x8;
struct UAux { u32x4 h; float p0, p1, g0, g1; };
DI void gatherU_phase(const Params& P, int layer, char* smem) {
  const int lane = tidx() & 63, wv = tidx() >> 6, rg = lane >> 3, cl = lane & 7, r16 = lane & 15, q = lane >> 4;
  const bf16* h = (const bf16*)(P.ws + WS_H);
  const unsigned char* ut = (const unsigned char*)(P.ws + WS_PU) + (size_t)layer * 4 * 16384 * 128;
  const int* idx = (const int*)(P.ws + WS_IDX);
  const float* gg = (const float*)(P.ws + WS_G);
  float* act = (float*)(P.ws + WS_ACT);
  char* T = smem + wv * 18432;
  int* s_idx = (int*)(smem + wv * 18432 + 17408);
  float* s_part = (float*)(smem + wv * 18432 + 17920);
  const int gw = blockIdx.x * 4 + wv, nw = gridDim.x * 4;
  const int K = gw < NTOK ? (NTOK - 1 - gw) / nw + 1 : 0;
  for (int c = 0; c < 4; ++c) {
    const unsigned char* uts = ut + (size_t)c * 16384 * 128 + cl * 16;
    auto load_idx = [&](int tok, int& i0, int& i1) { i0 = idx[(size_t)tok * 128 + lane]; i1 = idx[(size_t)tok * 128 + 64 + lane]; };
    auto load_aux = [&](UAux& ax, int tok) {
      ax.h = *(const u32x4*)(h + (size_t)tok * D + c * 256 + ((r16 & 7) >> 2) * 128 + q * 32 + (r16 & 3) * 8);
      ax.p0 = 0.f; ax.p1 = 0.f; ax.g0 = 0.f; ax.g1 = 0.f;
      if (c > 0) {
        ax.p0 = __hip_atomic_load(act + (size_t)tok * 128 + lane, __ATOMIC_RELAXED, __HIP_MEMORY_SCOPE_AGENT);
        ax.p1 = __hip_atomic_load(act + (size_t)tok * 128 + 64 + lane, __ATOMIC_RELAXED, __HIP_MEMORY_SCOPE_AGENT);
      }
      if (c == 3) { ax.g0 = gg[(size_t)tok * 128 + lane]; ax.g1 = gg[(size_t)tok * 128 + 64 + lane]; }
    };
    auto compute = [&](const u32x4(&rows)[16], const UAux& ax, int tok) {
      i32x8 hb1[2], hb2[2];
      {
        const u32x4 hv = ax.h;
        unsigned w1 = 0, w2 = 0;
#pragma unroll
        for (int e = 0; e < 4; ++e) {
          const float f0 = bf_lo(hv[e]) * PEER_HS, f1 = bf_hi(hv[e]) * PEER_HS;
          if (e == 0) w1 = __builtin_amdgcn_cvt_scalef32_pk_fp4_f32(w1, f0, f1, 1.0f, 0);
          else if (e == 1) w1 = __builtin_amdgcn_cvt_scalef32_pk_fp4_f32(w1, f0, f1, 1.0f, 1);
          else if (e == 2) w1 = __builtin_amdgcn_cvt_scalef32_pk_fp4_f32(w1, f0, f1, 1.0f, 2);
          else w1 = __builtin_amdgcn_cvt_scalef32_pk_fp4_f32(w1, f0, f1, 1.0f, 3);
        }
#pragma unroll
        for (int e = 0; e < 4; ++e) {
          const fl2_t d = dec4(w1, e);
          const float r0 = (bf_lo(hv[e]) * PEER_HS - d[0]) * 4.f, r1 = (bf_hi(hv[e]) * PEER_HS - d[1]) * 4.f;
          if (e == 0) w2 = __builtin_amdgcn_cvt_scalef32_pk_fp4_f32(w2, r0, r1, 1.0f, 0);
          else if (e == 1) w2 = __builtin_amdgcn_cvt_scalef32_pk_fp4_f32(w2, r0, r1, 1.0f, 1);
          else if (e == 2) w2 = __builtin_amdgcn_cvt_scalef32_pk_fp4_f32(w2, r0, r1, 1.0f, 2);
          else w2 = __builtin_amdgcn_cvt_scalef32_pk_fp4_f32(w2, r0, r1, 1.0f, 3);
        }
        unsigned* s_h = (unsigned*)s_idx;
        wave_fence();
        s_h[q * 16 + r16] = r16 < 8 ? w1 : w2;
        wave_fence();
        const u32x4 a0 = *(const u32x4*)(s_h + q * 16), a1 = *(const u32x4*)(s_h + q * 16 + 4);
        const u32x4 b0 = *(const u32x4*)(s_h + q * 16 + 8), b1 = *(const u32x4*)(s_h + q * 16 + 12);
        hb1[0] = i32x8{(int)a0[0], (int)a0[1], (int)a0[2], (int)a0[3], 0, 0, 0, 0};
        hb1[1] = i32x8{(int)a1[0], (int)a1[1], (int)a1[2], (int)a1[3], 0, 0, 0, 0};
        hb2[0] = i32x8{(int)b0[0], (int)b0[1], (int)b0[2], (int)b0[3], 0, 0, 0, 0};
        hb2[1] = i32x8{(int)b1[0], (int)b1[1], (int)b1[2], (int)b1[3], 0, 0, 0, 0};
      }
      wave_fence();
#pragma unroll
      for (int rb = 0; rb < 16; ++rb) {
        char* tp = T + (rb * 8 + rg) * 136 + cl * 16;
        *(u32x2*)tp = u32x2{rows[rb][0], rows[rb][1]};
        *(u32x2*)(tp + 8) = u32x2{rows[rb][2], rows[rb][3]};
      }
      wave_fence();
#pragma unroll
      for (int mt = 0; mt < 8; ++mt) {
        f32x4 acc = {0.f, 0.f, 0.f, 0.f};
#pragma unroll
        for (int s2 = 0; s2 < 2; ++s2) {
          const char* tp = T + (mt * 16 + r16) * 136 + s2 * 64 + q * 16;
          const u32x2 lo = *(const u32x2*)tp, hi = *(const u32x2*)(tp + 8);
          const i32x8 av = {(int)lo[0], (int)lo[1], (int)hi[0], (int)hi[1], 0, 0, 0, 0};
          acc = __builtin_amdgcn_mfma_scale_f32_16x16x128_f8f6f4(av, hb1[s2], acc, 4, 4, 0, 127, 0, 127);
          acc = __builtin_amdgcn_mfma_scale_f32_16x16x128_f8f6f4(av, hb2[s2], acc, 4, 4, 0, 127, 0, 125);
        }
        if (r16 == 0) *(f32x4*)(s_part + mt * 16 + 4 * q) = acc;
      }
      wave_fence();
      float v0 = s_part[lane] * (1.f / PEER_HS) + ax.p0, v1 = s_part[64 + lane] * (1.f / PEER_HS) + ax.p1;
      if (c == 3) {
        v0 = gelu_tanh(v0 * (1.f / PEER_SU)) * ax.g0 * (1.f / PEER_SV);
        v1 = gelu_tanh(v1 * (1.f / PEER_SU)) * ax.g1 * (1.f / PEER_SV);
      }
      act[(size_t)tok * 128 + lane] = v0;
      act[(size_t)tok * 128 + 64 + lane] = v1;
    };
    if (K == 0) continue;
    u32x4 rA[16];
    UAux xA, xN;
    int i0, i1;
    load_idx(gw, i0, i1);
    load_aux(xN, gw);
#pragma unroll 1
    for (int k = 0; k < K; ++k) {
      const int tok = gw + k * nw;
      xA = xN;
      wave_fence();
      s_idx[lane] = i0; s_idx[64 + lane] = i1;
      wave_fence();
#pragma unroll
      for (int rb = 0; rb < 16; ++rb) { const int e = s_idx[rb * 8 + rg]; rA[rb] = *(const u32x4*)(uts + (size_t)e * 128); }
      if (k + 1 < K) { load_idx(tok + nw, i0, i1); load_aux(xN, tok + nw); }
      compute(rA, xA, tok);
    }
  }
}

constexpr float PEER_XS = 2.f * PEER_SV;
typedef __attribute__((ext_vector_type(2))) int i32x2;
typedef __attribute__((address_space(3))) i32x2* lds_i32x2_ptr;
struct VAux { float a0, a1; f32x4 xv, gt; };
DI unsigned enc4x8(const float (&x)[8]) {
  unsigned w = 0;
  w = __builtin_amdgcn_cvt_scalef32_pk_fp4_f32(w, x[0], x[1], 1.0f, 0);
  w = __builtin_amdgcn_cvt_scalef32_pk_fp4_f32(w, x[2], x[3], 1.0f, 1);
  w = __builtin_amdgcn_cvt_scalef32_pk_fp4_f32(w, x[4], x[5], 1.0f, 2);
  w = __builtin_amdgcn_cvt_scalef32_pk_fp4_f32(w, x[6], x[7], 1.0f, 3);
  return w;
}
DI void resid4x8(float (&x)[8], unsigned w) {
#pragma unroll
  for (int e = 0; e < 4; ++e) { const fl2_t d = dec4(w, e); x[2 * e] = (x[2 * e] - d[0]) * 4.f; x[2 * e + 1] = (x[2 * e + 1] - d[1]) * 4.f; }
}
DI void gatherV_phase(const Params& P, int layer, char* smem) {
  const int lane = tidx() & 63, wv = tidx() >> 6, rg = lane >> 3, cl = lane & 7, r16 = lane & 15, q = lane >> 4;
  const float* mod = (const float*)(P.ws + WS_MOD) + (size_t)layer * 9 * 6144 + 5 * 1024;
  bf16* x = (bf16*)(P.ws + WS_X);
  const unsigned char* vt = (const unsigned char*)(P.ws + WS_PV) + (size_t)layer * 4 * 16384 * 128;
  const int* idx = (const int*)(P.ws + WS_IDX);
  const float* act = (const float*)(P.ws + WS_ACT);
  char* T = smem + wv * 18432;
  int* s_idx = (int*)(smem + wv * 18432 + 17408);
  float* s_act = (float*)(smem + wv * 18432 + 17920);
  const int gw = blockIdx.x * 4 + wv, nw = gridDim.x * 4;
  const int K = gw < NTOK ? (NTOK - 1 - gw) / nw + 1 : 0;
  for (int c = 0; c < 4; ++c) {
    const unsigned char* vts = vt + (size_t)c * 16384 * 128 + cl * 16;
    auto load_tok = [&](int tok, int& i0, int& i1, VAux& ax) {
      i0 = idx[(size_t)tok * 128 + lane]; i1 = idx[(size_t)tok * 128 + 64 + lane];
      ax.a0 = act[(size_t)tok * 128 + lane]; ax.a1 = act[(size_t)tok * 128 + 64 + lane];
      ax.xv = unpack4(*(const u32x2*)(x + (size_t)tok * D + c * 256 + 4 * lane));
      ax.gt = *(const f32x4*)(mod + (size_t)cond_of(tok) * 6144 + c * 256 + 4 * lane);
    };
    if (K == 0) continue;
    u32x4 rows[16];
    VAux xA, xN;
    int i0, i1;
    load_tok(gw, i0, i1, xN);
#pragma unroll 1
    for (int k = 0; k < K; ++k) {
      const int tok = gw + k * nw;
      xA = xN;
      wave_fence();
      s_idx[lane] = i0; s_idx[64 + lane] = i1;
      s_act[lane] = xA.a0; s_act[64 + lane] = xA.a1;
      wave_fence();
#pragma unroll
      for (int rb = 0; rb < 16; ++rb) { const int e = s_idx[rb * 8 + rg]; rows[rb] = *(const u32x4*)(vts + (size_t)e * 128); }
      if (k + 1 < K) load_tok(tok + nw, i0, i1, xN);
      i32x8 a1v, a2v, a3v, a4v;
      {
        float xv8[8];
        const int d = r16 & 3, term = r16 >> 2;
        const f32x4 s0 = *(const f32x4*)(s_act + 32 * q + 8 * d), s1 = *(const f32x4*)(s_act + 32 * q + 8 * d + 4);
#pragma unroll
        for (int e = 0; e < 4; ++e) { xv8[e] = s0[e] * PEER_XS; xv8[4 + e] = s1[e] * PEER_XS; }
        unsigned w = enc4x8(xv8);
        if (term >= 1) { resid4x8(xv8, w); w = enc4x8(xv8); }
        if (term >= 2) { resid4x8(xv8, w); w = enc4x8(xv8); }
        if (term >= 3) { resid4x8(xv8, w); w = enc4x8(xv8); }
        unsigned* s_h = (unsigned*)s_idx;
        wave_fence();
        s_h[q * 16 + term * 4 + d] = w;
        wave_fence();
        const unsigned* hp = s_h + q * 16;
        a1v = i32x8{(int)hp[0], (int)hp[1], (int)hp[2], (int)hp[3], 0, 0, 0, 0};
        a2v = i32x8{(int)hp[4], (int)hp[5], (int)hp[6], (int)hp[7], 0, 0, 0, 0};
        a3v = i32x8{(int)hp[8], (int)hp[9], (int)hp[10], (int)hp[11], 0, 0, 0, 0};
        a4v = i32x8{(int)hp[12], (int)hp[13], (int)hp[14], (int)hp[15], 0, 0, 0, 0};
      }
      wave_fence();
#pragma unroll
      for (int rb = 0; rb < 16; ++rb) {
        char* tp = T + (rb * 8 + rg) * 136 + cl * 16;
        *(u32x2*)tp = u32x2{rows[rb][0], rows[rb][1]};
        *(u32x2*)(tp + 8) = u32x2{rows[rb][2], rows[rb][3]};
      }
      wave_fence();
      float outv[16];
#pragma unroll
      for (int nt = 0; nt < 16; ++nt) {
        const i32x2 b01 = __builtin_amdgcn_ds_read_tr4_b64_v2i32((lds_i32x2_ptr)(T + (32 * q + r16) * 136 + nt * 8));
        const i32x2 b23 = __builtin_amdgcn_ds_read_tr4_b64_v2i32((lds_i32x2_ptr)(T + (32 * q + 16 + r16) * 136 + nt * 8));
        const i32x8 bv = {b01[0], b01[1], b23[0], b23[1], 0, 0, 0, 0};
        f32x4 acc = {0.f, 0.f, 0.f, 0.f};
        acc = __builtin_amdgcn_mfma_scale_f32_16x16x128_f8f6f4(a1v, bv, acc, 4, 4, 0, 127, 0, 127);
        acc = __builtin_amdgcn_mfma_scale_f32_16x16x128_f8f6f4(a2v, bv, acc, 4, 4, 0, 125, 0, 127);
        acc = __builtin_amdgcn_mfma_scale_f32_16x16x128_f8f6f4(a3v, bv, acc, 4, 4, 0, 123, 0, 127);
        acc = __builtin_amdgcn_mfma_scale_f32_16x16x128_f8f6f4(a4v, bv, acc, 4, 4, 0, 121, 0, 127);
        outv[nt] = acc[0];
      }
      wave_fence();
      float* s_out = (float*)T;
      if (q == 0) {
#pragma unroll
        for (int nt = 0; nt < 16; ++nt) s_out[nt * 16 + r16] = outv[nt];
      }
      wave_fence();
      const f32x4 sum = *(const f32x4*)(s_out + 4 * lane);
      f32x4 res;
#pragma unroll
      for (int e = 0; e < 4; ++e) res[e] = DN_ALPHA * xA.xv[e] + (1.f + xA.gt[e]) * sum[e] * (1.f / PEER_XS);
      *(u32x2*)(x + (size_t)tok * D + c * 256 + 4 * lane) = u32x2{pack_bf16(res[0], res[1]), pack_bf16(res[2], res[3])};
    }
  }
}

constexpr int ST_LD = 68;
constexpr int ST_WAVE_BYTES = 64 * ST_LD * 4;
template <class F>
DI void wave_tile_epilogue(f32x16 (&acc)[2][2], char* smem, const F& f) {
  const int lane = tidx() & 63, wv = tidx() >> 6, r31 = lane & 31, hh = lane >> 5;
  float* st = (float*)(smem + wv * ST_WAVE_BYTES);
#pragma unroll
  for (int mi = 0; mi < 2; ++mi)
#pragma unroll
    for (int ni = 0; ni < 2; ++ni)
#pragma unroll
      for (int i = 0; i < 16; ++i) st[(mi * 32 + crow(i, hh)) * ST_LD + ni * 32 + r31] = acc[mi][ni][i];
  wave_fence();
#pragma unroll 2
  for (int it = 0; it < 8; ++it) {
    const int row = it * 8 + (lane >> 3), c0 = (lane & 7) * 8;
    f(row, c0, (const float*)(st + row * ST_LD));
  }
}
DI void ld8(const float* p, float (&v)[8]) {
  const f32x4 a = *(const f32x4*)p, b = *(const f32x4*)(p + 4);
  v[0] = a[0]; v[1] = a[1]; v[2] = a[2]; v[3] = a[3]; v[4] = b[0]; v[5] = b[1]; v[6] = b[2]; v[7] = b[3];
}
DI void st8(float* p, const float (&v)[8]) {
  *(f32x4*)p = f32x4{v[0], v[1], v[2], v[3]};
  *(f32x4*)(p + 4) = f32x4{v[4], v[5], v[6], v[7]};
}
DI u32x4 pack8(const float (&v)[8]) { return u32x4{pack_bf16(v[0], v[1]), pack_bf16(v[2], v[3]), pack_bf16(v[4], v[5]), pack_bf16(v[6], v[7])}; }

#define XB_TMO      128
#define XB_XCNT(j)  (256  + 64 * (j))
#define XB_XSUB(j)  (1280 + 64 * (j))
#define XB_XGEN(j)  (2304 + 64 * (j))
#define XB_TOP      3328
#define XB_TOPGEN   3392
#define XCD_BAR_WORDS 3456
#define XB_SPIN_CAP (1u << 18)
#define LAS __attribute__((address_space(3)))
DI unsigned xb_ld(unsigned* p) { return __hip_atomic_load(p, __ATOMIC_RELAXED, __HIP_MEMORY_SCOPE_AGENT); }
DI unsigned xb_add(unsigned* p, unsigned v) { return __hip_atomic_fetch_add(p, v, __ATOMIC_RELAXED, __HIP_MEMORY_SCOPE_AGENT); }
DI unsigned xb_xcc_id() { return (unsigned)__builtin_amdgcn_s_getreg((3 << 11) | 20) & 0xFu; }
#define XB_SPIN(cond, bar) do { unsigned _sp = 0; while (cond) { __builtin_amdgcn_s_sleep(1); \
    if ((++_sp & 255u) == 0u) { if (xb_ld(&(bar)[XB_TMO])) break; if (_sp > XB_SPIN_CAP) { atomicAdd(&(bar)[XB_TMO], 1u); break; } } } } while (0)
struct XcdBarrier { unsigned* bar; unsigned x; volatile LAS unsigned* st; };
DI XcdBarrier xcd_barrier_post(unsigned* bar, volatile LAS unsigned* st) {
  XcdBarrier b; b.bar = bar; b.x = xb_xcc_id(); b.st = st;
  if (__builtin_amdgcn_workitem_id_x() == 0) (void)xb_add(&bar[XB_XCNT(b.x)], 1u);
  return b;
}
DI void xcd_barrier_complete(unsigned* bar, unsigned x, unsigned& nloc, unsigned& nx) {
  const unsigned G = gridDim.x * gridDim.y * gridDim.z;
  unsigned sum, cnt, mine, sp = 0u;
  for (;;) {
    sum = 0u; cnt = 0u; mine = 0u;
#pragma unroll
    for (unsigned j = 0; j < 16; ++j) { const unsigned c = xb_ld(&bar[XB_XCNT(j)]); sum += c; cnt += (c > 0u) ? 1u : 0u; mine = (j == x) ? c : mine; }
    if (sum == G) break;
    __builtin_amdgcn_s_sleep(1);
    if ((++sp & 255u) == 0u) { if (xb_ld(&bar[XB_TMO])) break; if (sp > XB_SPIN_CAP) { atomicAdd(&bar[XB_TMO], 1u); break; } }
  }
  nloc = mine > 0u ? mine : 1u; nx = cnt > 0u ? cnt : 1u;
}
DI void xcd_barrier(const XcdBarrier& b) {
  asm volatile("s_waitcnt vmcnt(0)" ::: "memory");
  __syncthreads();
  if (__builtin_amdgcn_workitem_id_x() == 0) {
    unsigned* bar = b.bar;
    __builtin_amdgcn_s_waitcnt(0);
    unsigned nloc = b.st[0], nx = b.st[1];
    if (nloc == 0u) { xcd_barrier_complete(bar, b.x, nloc, nx); b.st[0] = nloc; b.st[1] = nx; }
    const unsigned old = xb_add(&bar[XB_XSUB(b.x)], 1u);
    const unsigned gen = old / nloc;
    if (old + 1u == (gen + 1u) * nloc) {
      __builtin_amdgcn_fence(__ATOMIC_RELEASE, "agent");
      asm volatile("s_waitcnt vmcnt(0)" ::: "memory");
      const unsigned og = xb_add(&bar[XB_TOP], 1u);
      const unsigned tg = og / nx;
      if (og + 1u == (tg + 1u) * nx) xb_add(&bar[XB_TOPGEN], 1u);
      else XB_SPIN(xb_ld(&bar[XB_TOPGEN]) == tg, bar);
      __builtin_amdgcn_fence(__ATOMIC_ACQUIRE, "agent");
      xb_add(&bar[XB_XGEN(b.x)], 1u);
      asm volatile("s_waitcnt vmcnt(0)" ::: "memory");
    } else {
      XB_SPIN(xb_ld(&bar[XB_XGEN(b.x)]) == gen, bar);
      __builtin_amdgcn_fence(__ATOMIC_ACQUIRE, "agent");
      asm volatile("s_waitcnt vmcnt(0)" ::: "memory");
    }
  }
  __syncthreads();
}

typedef const Params __attribute__((address_space(4)))* KParamPtr;
DI Params load_params() {
#if defined(__HIP_DEVICE_COMPILE__)
  KParamPtr kp = (KParamPtr)__builtin_amdgcn_kernarg_segment_ptr();
  asm volatile("" : "+s"(kp));
  return *kp;
#else
  return Params{};
#endif
}
__global__ void __launch_bounds__(256, 2) fwd_kernel(Params PK) {
  const int p0 = PK.p0, p1 = PK.p1;
  __shared__ __attribute__((aligned(16))) char smem[SMEM_BYTES];
  __shared__ uint4 xb_words;
  cg::grid_group grid = cg::this_grid();
  if (__builtin_amdgcn_workitem_id_x() == 0) xb_words = make_uint4(0u, 0u, 0u, 0u);
  __syncthreads();
  XcdBarrier xb;
  xb.bar = (unsigned*)(PK.ws + WS_BAR); xb.x = 0; xb.st = (volatile LAS unsigned*)&xb_words;
  if (p1 - p0 > 1) xb = xcd_barrier_post((unsigned*)(PK.ws + WS_BAR), (volatile LAS unsigned*)&xb_words);
  int ph = 0;
#ifndef SITEMASK
#define SITEMASK 0xFFFF
#endif
#define PH_BEGIN(id) if (((SITEMASK >> (id)) & 1) && ph >= p0 && ph < p1) { const Params P = load_params();
#define PH_END if (ph + 1 < p1) { if (ph == p0) { asm volatile("s_waitcnt vmcnt(0)" ::: "memory"); grid.sync(); } else xcd_barrier(xb); } } ++ph;
  PH_BEGIN(0) conv_phase(P, smem); PH_END
  PH_BEGIN(1) prep_phase(P); PH_END
  for (int layer = 0; layer < DEPTH; ++layer) {
    const int j = layer >> 1;
    if ((layer & 1) == 0) {
      PH_BEGIN(2) {
        bf16* ub = (bf16*)(P.ws + WS_U);
        auto epi = [&](f32x16(&acc)[2][2], int row0, int col0) {
          wave_tile_epilogue(acc, smem, [&](int row, int c0, const float* rp) {
            float v[8];
            ld8(rp + c0, v);
            *(u32x4*)(ub + (size_t)(row0 + row) * 1024 + col0 + c0) = pack8(v);
          });
        };
        gemm_phase(1024, PlainALF{(const bf16*)(P.ws + WS_H)}, (const bf16*)(P.ws + WS_WIN) + (size_t)j * 1048576, epi, smem);
      } PH_END
      PH_BEGIN(3) scan_phase(P, j, smem); PH_END
      PH_BEGIN(11) comb_phase(P, j); PH_END
      PH_BEGIN(4) {
        bf16* zb = (bf16*)(P.ws + WS_Z);
        auto epi = [&](f32x16(&acc)[2][2], int row0, int col0) {
          wave_tile_epilogue(acc, smem, [&](int row, int c0, const float* rp) {
            if (c0 < 32) {
              float v[8], g[8];
              ld8(rp + c0, v);
              ld8(rp + 32 + c0, g);
#pragma unroll
              for (int e = 0; e < 8; ++e) v[e] *= sigmoidf_(g[e]);
              *(u32x4*)(zb + (size_t)(row0 + row) * 1024 + (col0 >> 1) + c0) = pack8(v);
            }
          });
        };
        gemm_phase(2048, PlainALF{(const bf16*)(P.ws + WS_YF)}, (const bf16*)(P.ws + WS_WGLU) + (size_t)j * 2097152, epi, smem);
      } PH_END
    } else {
      PH_BEGIN(5) {
        bf16* qb = (bf16*)(P.ws + WS_U);
        bf16* kb = (bf16*)(P.ws + WS_YF);
        bf16* vb = (bf16*)(P.ws + WS_YB);
        const float* rt = (const float*)(P.ws + WS_ROPE);
        auto epi = [&](f32x16(&acc)[2][2], int row0, int col0) {
          const bool lat = row0 >= NCTX;
          wave_tile_epilogue(acc, smem, [&](int row, int c0, const float* rp) {
            const int tok = row0 + row;
            float v[8];
            ld8(rp + c0, v);
            if (lat && col0 < 1280) {
              const int pos = (tok - NCTX) & 4095;
              const int pp = (c0 & 32) ? (pos & 63) : (pos >> 6);
              const bool second = (c0 & 16) != 0;
              float o[8], cs[8], sn[8];
              ld8(rp + (second ? c0 - 16 : c0 + 16), o);
              ld8(rt + pp * 16 + (c0 & 15), cs);
              ld8(rt + 1024 + pp * 16 + (c0 & 15), sn);
#pragma unroll
              for (int e = 0; e < 8; ++e) v[e] = second ? (o[e] * sn[e] + v[e] * cs[e]) : (v[e] * cs[e] - o[e] * sn[e]);
            }
            if (col0 < 1024) {
              *(u32x4*)(qb + (size_t)tok * 1024 + col0 + c0) = pack8(v);
            } else if (col0 < 1280) {
              *(u32x4*)(kb + (size_t)tok * 256 + col0 - 1024 + c0) = pack8(v);
              if (!lat) st8(P.out + OUT_CK + (((size_t)(tok >> 8) * 2 + j) * 256 + (tok & 255)) * 256 + col0 - 1024 + c0, v);
            } else {
              *(u32x4*)(vb + (size_t)tok * 256 + col0 - 1280 + c0) = pack8(v);
              if (!lat) st8(P.out + OUT_CV + (((size_t)(tok >> 8) * 2 + j) * 256 + (tok & 255)) * 256 + col0 - 1280 + c0, v);
            }
          });
        };
        gemm_phase(1536, PlainALF{(const bf16*)(P.ws + WS_H)}, (const bf16*)(P.ws + WS_WQKV) + (size_t)j * 1572864, epi, smem);
      } PH_END
      PH_BEGIN(6) attn_phase(P, j, smem); PH_END
    }
    PH_BEGIN(7) {
      const float* mod = (const float*)(P.ws + WS_MOD) + (size_t)layer * 9 * 6144;
      bf16* xbuf = (bf16*)(P.ws + WS_X);
      auto epi = [&](f32x16(&acc)[2][2], int row0, int col0) {
        const float* m = mod + (size_t)cond_of(row0) * 6144 + 2 * 1024 + col0;
        wave_tile_epilogue(acc, smem, [&](int row, int c0, const float* rp) {
          float v[8], xv[8], gt[8];
          ld8(rp + c0, v);
          bf16* xp = xbuf + (size_t)(row0 + row) * 1024 + col0 + c0;
          { const u32x4 xw = *(const u32x4*)xp;
#pragma unroll
            for (int e = 0; e < 4; ++e) { xv[2 * e] = bf_lo(xw[e]); xv[2 * e + 1] = bf_hi(xw[e]); } }
          ld8(m + c0, gt);
#pragma unroll
          for (int e = 0; e < 8; ++e) xv[e] = DN_ALPHA * xv[e] + (1.f + gt[e]) * v[e];
          *(u32x4*)xp = pack8(xv);
        });
      };
      const bf16* wt = (layer & 1) == 0 ? (const bf16*)(P.ws + WS_WOUT) + (size_t)j * 1048576 : (const bf16*)(P.ws + WS_AWOUT) + (size_t)j * 1048576;
      gemm_phase(1024, PlainALF{(const bf16*)(P.ws + WS_Z)}, wt, epi, smem);
    } PH_END
    PH_BEGIN(8) ln_phase(P, layer, 0); PH_END
    PH_BEGIN(9) route_phase(P, layer, smem); PH_END
    PH_BEGIN(10)
      gatherU_phase(P, layer, smem);
      asm volatile("s_waitcnt vmcnt(0)" ::: "memory"); __builtin_amdgcn_fence(__ATOMIC_ACQUIRE, "agent"); asm volatile("s_waitcnt vmcnt(0)" ::: "memory");
      __syncthreads();
      gatherV_phase(P, layer, smem);
      asm volatile("s_waitcnt vmcnt(0)" ::: "memory"); __builtin_amdgcn_fence(__ATOMIC_ACQUIRE, "agent"); asm volatile("s_waitcnt vmcnt(0)" ::: "memory");
      ln_phase(P, layer, 1);
    PH_END
  }
}

constexpr int N_PHASES = 2 + 2 * 8 + 2 * 6;

extern "C" void kernel_launch(void* const* d_in, const int* in_sizes, int n_in, void* d_out, int out_size, void* d_ws, size_t ws_size, hipStream_t stream) {
  static int grid_blocks = 0;
  if (!grid_blocks) {
    int dev = 0, cus = 0, per_cu = 0;
    (void)hipGetDevice(&dev);
    (void)hipDeviceGetAttribute(&cus, hipDeviceAttributeMultiprocessorCount, dev);
    (void)hipOccupancyMaxActiveBlocksPerMultiprocessor(&per_cu, fwd_kernel, 256, 0);
    if (per_cu < 1) per_cu = 1;
    if (per_cu > 2) per_cu = 2;
    grid_blocks = cus * per_cu;
    if (ws_size < WS_END) fprintf(stderr, "kernel_launch: workspace too small: %zu < %zu\n", ws_size, (size_t)WS_END);
  }
  Params p;
  memset(&p, 0, sizeof(p));
  const float** fp = (const float**)&p;
  for (int i = 0; i < 30; ++i) fp[i] = (const float*)d_in[i];
  p.out = (float*)d_out;
  p.ws = (char*)d_ws;
  (void)hipMemsetAsync((char*)d_ws + WS_BAR, 0, XCD_BAR_WORDS * sizeof(unsigned), stream);
#if MULTI_LAUNCH
  for (int ph = 0; ph < N_PHASES; ++ph) {
    p.p0 = ph; p.p1 = ph + 1;
    hipLaunchKernelGGL(fwd_kernel, dim3(grid_blocks), dim3(256), 0, stream, p);
  }
#else
  p.p0 = 0; p.p1 = N_PHASES;
  void* args[] = {&p};
  hipError_t e = hipLaunchCooperativeKernel((void*)fwd_kernel, dim3(grid_blocks), dim3(256), args, 0, stream);
  if (e != hipSuccess) fprintf(stderr, "cooperative launch failed: %s (grid %d)\n", hipGetErrorString(e), grid_blocks);
#endif
}
```
